# Optimizing an MI355X kernel written in HIP

```python
import math
import jax, jax.numpy as jnp
from jax import lax
import numpy as np


D_MODEL = 1024
BATCH = 16
SEQ = 2048
DEPTH = 2

HEAD_DIM = 64
BRANCH_WIDTH = D_MODEL // 2
N_BRANCHES = 3
DIFF_HEADS = BRANCH_WIDTH // (2 * HEAD_DIM)
RET_HEAD_DIM = 2 * HEAD_DIM
RET_HEADS = BRANCH_WIDTH // RET_HEAD_DIM
FOX_HEADS = BRANCH_WIDTH // HEAD_DIM
IN_SPLITS = (BRANCH_WIDTH,) * 3 + (BRANCH_WIDTH,) * 4 + (BRANCH_WIDTH,) * 3 + (FOX_HEADS, N_BRANCHES * D_MODEL)
IN_COLS = 10 * BRANCH_WIDTH + FOX_HEADS + N_BRANCHES * D_MODEL
Q_BLOCK = 128
RET_CHUNK = 128
ROPE_BASE = 10000.0
RET_GAMMA_EXP0 = 5.0
FOX_BIAS_INIT = 3.0
N_EXPERTS = 32
TOP_K = 4
D_FF = D_MODEL
SWIGLU_LIMIT = 7.0
SWIGLU_ALPHA = 1.702
NORM_EPS = 1e-5
NEG_INF = -1e30

kernel_name = "hybrid_diffattn_retnet_fox_moe_adaln"


def _rms_norm(t, g=None):
    tf = t.astype(jnp.float32)
    out = tf * lax.rsqrt(jnp.mean(tf * tf, axis=-1, keepdims=True) + NORM_EPS)
    if g is not None:
        out = out * g.astype(jnp.float32)
    return out.astype(t.dtype)


def _group_norm_heads(t):
    tf = t.astype(jnp.float32)
    mu = jnp.mean(tf, axis=-1, keepdims=True)
    var = jnp.mean(jnp.square(tf - mu), axis=-1, keepdims=True)
    return ((tf - mu) * lax.rsqrt(var + NORM_EPS)).astype(t.dtype)


def _modulate(hn, shift, scale):
    return hn * (1.0 + scale[:, None, :]) + shift[:, None, :]


def _split_columns(t, sizes):
    outs = []
    start = 0
    for w in sizes:
        outs.append(t[..., start:start + w])
        start += w
    return outs


def _heads(t, n_heads):
    b, s, w = t.shape
    return t.reshape(b, s, n_heads, w // n_heads).transpose(0, 2, 1, 3)


def _merge_heads(t):
    b, h, s, d = t.shape
    return t.transpose(0, 2, 1, 3).reshape(b, s, h * d)


def _rotary(t, pos):
    d = t.shape[-1]
    inv = ROPE_BASE ** (-jnp.arange(0, d, 2, dtype=jnp.float32) / d)
    ang = pos.astype(jnp.float32)[:, None] * inv[None, :]
    cos = jnp.cos(ang).astype(t.dtype)
    sin = jnp.sin(ang).astype(t.dtype)
    t1, t2 = t[..., : d // 2], t[..., d // 2:]
    return jnp.concatenate([t1 * cos - t2 * sin, t1 * sin + t2 * cos], axis=-1)


def _causal_attention_blocked(q, k, v, fcum=None):
    b, h, s, dk = q.shape
    dv = v.shape[-1]
    nb = s // Q_BLOCK
    scale = dk ** -0.5
    key_pos = jnp.arange(s)
    qb = q.reshape(b, h, nb, Q_BLOCK, dk).transpose(2, 0, 1, 3, 4)
    xs = [jnp.arange(nb), qb]
    if fcum is not None:
        xs.append(fcum.reshape(b, h, nb, Q_BLOCK).transpose(2, 0, 1, 3))

    def one_block(args):
        i, q_i = args[0], args[1]
        sc = jnp.einsum('bhqd,bhkd->bhqk', q_i, k).astype(jnp.float32) * scale
        if fcum is not None:
            sc = sc + args[2][..., :, None] - fcum[:, :, None, :]
        q_pos = i * Q_BLOCK + jnp.arange(Q_BLOCK)
        sc = jnp.where(key_pos[None, :] <= q_pos[:, None], sc, NEG_INF)
        p = jax.nn.softmax(sc, axis=-1).astype(v.dtype)
        return jnp.einsum('bhqk,bhkv->bhqv', p, v)

    out = lax.map(one_block, tuple(xs))
    return out.transpose(1, 2, 0, 3, 4).reshape(b, h, s, dv)


def _retention_chunkwise(q, k, v, log_gamma):
    out_dtype = v.dtype
    q, k, v = q.astype(jnp.float32), k.astype(jnp.float32), v.astype(jnp.float32)
    b, h, s, dk = q.shape
    dv = v.shape[-1]
    nc = s // RET_CHUNK
    idx = jnp.arange(RET_CHUNK, dtype=jnp.float32)
    dist = idx[:, None] - idx[None, :]
    inner_decay = jnp.where(dist >= 0, jnp.exp(log_gamma[:, None, None] * jnp.maximum(dist, 0.0)), 0.0)
    q_decay = jnp.exp(log_gamma[:, None] * (idx + 1.0))
    k_decay = jnp.exp(log_gamma[:, None] * (RET_CHUNK - 1.0 - idx))
    chunk_decay = jnp.exp(log_gamma * RET_CHUNK)

    def to_chunks(t):
        return t.reshape(b, h, nc, RET_CHUNK, t.shape[-1]).transpose(2, 0, 1, 3, 4)

    def step(state, args):
        q_i, k_i, v_i = args
        sc = jnp.einsum('bhqd,bhkd->bhqk', q_i, k_i) * inner_decay[None]
        inner = jnp.einsum('bhqk,bhkv->bhqv', sc, v_i)
        cross = jnp.einsum('bhqd,bhdv->bhqv', q_i, state) * q_decay[None, :, :, None]
        new_state = state * chunk_decay[None, :, None, None] + jnp.einsum(
            'bhkd,bhkv->bhdv', k_i * k_decay[None, :, :, None], v_i)
        return new_state, inner + cross

    state0 = jnp.zeros((b, h, dk, dv), jnp.float32)
    _, out = lax.scan(step, state0, (to_chunks(q), to_chunks(k), to_chunks(v)))
    return out.transpose(1, 2, 0, 3, 4).reshape(b, h, s, dv).astype(out_dtype)


def _hybrid_mixer(h, w_in, gate_b, fox_fb, lam_q1, lam_k1, lam_q2, lam_k2, diff_subln_g,
                  w_branch, w_out, lam_init):
    s = h.shape[1]
    proj = jnp.einsum('bsd,dc->bsc', h, w_in)
    (dq, dk_, dv, rq, rk, rv, rg, fq, fk, fv, f_logit, gates) = _split_columns(proj, IN_SPLITS)

    q = _heads(dq, DIFF_HEADS)
    k = _heads(dk_, DIFF_HEADS)
    v = _heads(dv, DIFF_HEADS)
    a1 = _causal_attention_blocked(q[..., :HEAD_DIM], k[..., :HEAD_DIM], v)
    a2 = _causal_attention_blocked(q[..., HEAD_DIM:], k[..., HEAD_DIM:], v)
    lam = (jnp.exp(jnp.sum(lam_q1.astype(jnp.float32) * lam_k1.astype(jnp.float32)))
           - jnp.exp(jnp.sum(lam_q2.astype(jnp.float32) * lam_k2.astype(jnp.float32)))
           + lam_init)
    o_diff = a1 - lam.astype(a1.dtype) * a2
    o_diff = _merge_heads(_rms_norm(o_diff, diff_subln_g) * (1.0 - lam_init))

    pos = jnp.arange(s)
    q = _rotary(_heads(rq, RET_HEADS), pos)
    k = _rotary(_heads(rk, RET_HEADS), pos) * (RET_HEAD_DIM ** -0.5)
    v = _heads(rv, RET_HEADS)
    log_gamma = jnp.log1p(-jnp.exp2(-RET_GAMMA_EXP0 - jnp.arange(RET_HEADS, dtype=jnp.float32)))
    o_ret = _merge_heads(_group_norm_heads(_retention_chunkwise(q, k, v, log_gamma)))
    o_ret = o_ret.astype(h.dtype) * jax.nn.silu(rg)

    q = _heads(fq, FOX_HEADS)
    k = _heads(fk, FOX_HEADS)
    v = _heads(fv, FOX_HEADS)
    log_f = jax.nn.log_sigmoid((f_logit + fox_fb).astype(jnp.float32))
    fcum = jnp.cumsum(log_f, axis=1).transpose(0, 2, 1)
    o_fox = _merge_heads(_causal_attention_blocked(q, k, v, fcum))

    g = jax.nn.sigmoid(gates + gate_b)
    g_diff, g_ret, g_fox = jnp.split(g, N_BRANCHES, axis=-1)
    merged = (g_diff * jnp.einsum('bsw,wd->bsd', o_diff, w_branch[0])
              + g_ret * jnp.einsum('bsw,wd->bsd', o_ret, w_branch[1])
              + g_fox * jnp.einsum('bsw,wd->bsd', o_fox, w_branch[2]))
    return jnp.einsum('bsd,de->bse', merged, w_out)


def _moe_ffn(h, router_w, router_b, w_up, b_up, w_down, b_down):
    b, s, d = h.shape
    n = b * s
    hf = h.reshape(n, d)
    logits = (hf @ router_w + router_b).astype(jnp.float32)
    top_logits, top_idx = lax.top_k(logits, TOP_K)
    top_w = jax.nn.softmax(top_logits, axis=-1)
    flat_e = top_idx.reshape(-1)
    order = jnp.argsort(flat_e)
    sorted_e = flat_e[order]
    token_of = order // TOP_K
    xs = hf[token_of]
    group_sizes = jnp.bincount(flat_e, length=N_EXPERTS).astype(jnp.int32)
    up = lax.ragged_dot(xs, w_up, group_sizes) + b_up[sorted_e]
    glu = jnp.minimum(up[:, 0::2], SWIGLU_LIMIT)
    lin = jnp.clip(up[:, 1::2], -SWIGLU_LIMIT, SWIGLU_LIMIT)
    act = glu * jax.nn.sigmoid(SWIGLU_ALPHA * glu) * (lin + 1.0)
    down = lax.ragged_dot(act, w_down, group_sizes) + b_down[sorted_e]
    weighted = down * top_w.reshape(-1)[order][:, None].astype(down.dtype)
    out = jax.ops.segment_sum(weighted, token_of, num_segments=n)
    return out.reshape(b, s, d)


def setup_inputs(seed: int = 0) -> dict:
    key = jax.random.key(seed)
    ks = jax.random.split(key, 24)
    f32 = jnp.float32

    def nrm(k, shape, scale):
        return jax.random.normal(k, shape, f32) * scale

    return {
        "x": nrm(ks[0], (BATCH, SEQ, D_MODEL), 1.0),
        "c": nrm(ks[1], (BATCH, D_MODEL), 1.0),
        "norm1_g": 1.0 + nrm(ks[2], (DEPTH, D_MODEL), 0.02),
        "norm2_g": 1.0 + nrm(ks[3], (DEPTH, D_MODEL), 0.02),
        "ada_w": nrm(ks[4], (DEPTH, D_MODEL, 6 * D_MODEL), 0.5 * D_MODEL ** -0.5),
        "ada_b": nrm(ks[5], (DEPTH, 6 * D_MODEL), 0.02),
        "w_in": nrm(ks[6], (DEPTH, D_MODEL, IN_COLS), D_MODEL ** -0.5),
        "gate_b": nrm(ks[7], (DEPTH, N_BRANCHES * D_MODEL), 0.02),
        "fox_fb": FOX_BIAS_INIT + nrm(ks[8], (DEPTH, FOX_HEADS), 0.5),
        "lam_q1": nrm(ks[9], (DEPTH, HEAD_DIM), 0.1),
        "lam_k1": nrm(ks[10], (DEPTH, HEAD_DIM), 0.1),
        "lam_q2": nrm(ks[11], (DEPTH, HEAD_DIM), 0.1),
        "lam_k2": nrm(ks[12], (DEPTH, HEAD_DIM), 0.1),
        "diff_subln_g": 1.0 + nrm(ks[13], (DEPTH, 2 * HEAD_DIM), 0.02),
        "w_branch": nrm(ks[14], (DEPTH, N_BRANCHES, BRANCH_WIDTH, D_MODEL), BRANCH_WIDTH ** -0.5),
        "w_out": nrm(ks[15], (DEPTH, D_MODEL, D_MODEL), D_MODEL ** -0.5),
        "router_w": nrm(ks[16], (DEPTH, D_MODEL, N_EXPERTS), D_MODEL ** -0.5),
        "router_b": nrm(ks[17], (DEPTH, N_EXPERTS), 0.01),
        "exp_w_up": nrm(ks[18], (DEPTH, N_EXPERTS, D_MODEL, 2 * D_FF), D_MODEL ** -0.5),
        "exp_b_up": nrm(ks[19], (DEPTH, N_EXPERTS, 2 * D_FF), 0.02),
        "exp_w_down": nrm(ks[20], (DEPTH, N_EXPERTS, D_FF, D_MODEL), D_FF ** -0.5),
        "exp_b_down": nrm(ks[21], (DEPTH, N_EXPERTS, D_MODEL), 0.02),
        "final_g": 1.0 + nrm(ks[22], (D_MODEL,), 0.02),
    }


def reference(x, c, norm1_g, norm2_g, ada_w, ada_b, w_in, gate_b, fox_fb, lam_q1, lam_k1,
              lam_q2, lam_k2, diff_subln_g, w_branch, w_out, router_w, router_b,
              exp_w_up, exp_b_up, exp_w_down, exp_b_down, final_g):
    c_act = jax.nn.silu(c)
    for l in range(DEPTH):
        lam_init = 0.8 - 0.6 * math.exp(-0.3 * l)
        mod = c_act @ ada_w[l] + ada_b[l]
        sh1, sc1, g1, sh2, sc2, g2 = jnp.split(mod, 6, axis=-1)
        h = _modulate(_rms_norm(x, norm1_g[l]), sh1, sc1)
        mix = _hybrid_mixer(h, w_in[l], gate_b[l], fox_fb[l], lam_q1[l], lam_k1[l], lam_q2[l],
                            lam_k2[l], diff_subln_g[l], w_branch[l], w_out[l], lam_init)
        x = x + g1[:, None, :] * mix
        h = _modulate(_rms_norm(x, norm2_g[l]), sh2, sc2)
        ffn = _moe_ffn(h, router_w[l], router_b[l], exp_w_up[l], exp_b_up[l],
                       exp_w_down[l], exp_b_down[l])
        x = x + g2[:, None, :] * ffn
    return _rms_norm(x, final_g)
```

```cpp
#include <hip/hip_runtime.h>
#include <hip/hip_bf16.h>
#include <cstdio>
#include <cstdint>
#include <cmath>
namespace pg8 {
#define PG8_LAS __attribute__((address_space(3)))
typedef unsigned short bf16_t;
typedef short bf16x8 __attribute__((ext_vector_type(8)));
typedef float f32x4 __attribute__((ext_vector_type(4)));
typedef unsigned u32x4 __attribute__((ext_vector_type(4)));
constexpr int BM = 256, BK = 64, HALF = 128, HTB = HALF * BK * 2  , STAGE_BYTES = 8 * HTB, NXCD = 8, WGM = 8;

__host__ __device__ __forceinline__ int lds_byte(int r, int c) { const int st = (r >> 4) * 2 + (c >> 5), rr = r & 15, cc = c & 31, ob = rr * 64 + cc * 2; return st * 1024 + (ob ^ (((ob >> 9) & 1) << 5)); }
__host__ __device__ __forceinline__ void stage_rc(int b, int& R, int& C) { const int st = b / 1024, sb = b % 1024, swz = sb ^ (((sb >> 9) & 1) << 5); R = (st >> 1) * 16 + swz / 64; C = (st & 1) * 32 + (swz % 64) / 2; }
__host__ __device__ __forceinline__ int perm32(int rho) { const int n = rho >> 4, i = rho & 15; return 8 * (i >> 2) + 4 * n + (i & 3); }

struct Unit { int pm, pn, e; };
struct Gemm { const bf16_t* A; const bf16_t* Bt; int M, N, K; size_t estride; };

struct StaticOrder {
    int nM, nN, nwg, G, c;
    __host__ __device__ void init(int M, int N, int G_, int c_) { nM = M / BM; nN = N / BM; nwg = nM * nN; G = G_; c = c_; }
    __host__ __device__ bool next(int i, Unit& u) const {
        const long L = (long)i * G + c; if (L >= nwg) return false;
        int wgid = (int)L; { const int q = nwg / NXCD, r = nwg % NXCD, xcd = wgid % NXCD, off = wgid / NXCD; wgid = (xcd < r ? xcd * (q + 1) : r * (q + 1) + (xcd - r) * q) + off; }
        const int nig = WGM * nN, gid = wgid / nig, fm = gid * WGM, gsz = (nM - fm) < WGM ? (nM - fm) : WGM;
        u.pm = fm + ((wgid % nig) % gsz); u.pn = (wgid % nig) / gsz; u.e = 0; return true;
    }
    __device__ __forceinline__ void a_ready(const Unit&) const {}
    __device__ __forceinline__ void done(const Unit&) const {}
};
struct GroupOrder {
    int nN, ntiles, G, c; const int* tile_e;
    __device__ __forceinline__ bool next(int i, Unit& u) const {
        int pm, pn;
        if (G % (NXCD * nN) == 0) { const int rpr = G / nN, rpx = rpr / NXCD, x = c % NXCD, j = c / NXCD; pm = i * rpr + x * rpx + (j % rpx); pn = j / rpx; }
        else { const long L = (long)i * G + c; pm = (int)(L / nN); pn = (int)(L % nN); }
        if (pm >= ntiles) return false;
        u.pm = pm; u.pn = pn; u.e = __builtin_amdgcn_readfirstlane(tile_e[pm]); return true;
    }
    __device__ __forceinline__ void a_ready(const Unit&) const {}
    __device__ __forceinline__ void done(const Unit&) const {}
};
__device__ __forceinline__ unsigned cvt_pk_bf16(float lo, float hi) { typedef float f2_t __attribute__((ext_vector_type(2))); typedef __bf16 b2_t __attribute__((ext_vector_type(2))); const f2_t v = {lo, hi}; const b2_t b = __builtin_convertvector(v, b2_t); return __builtin_bit_cast(unsigned, b); }

template <class Epi, class Sched, bool ALIGN_EPI = false, bool SP2 = false>
__device__ __forceinline__ void gemm_phase(PG8_LAS unsigned char* lds, const Gemm g, const Sched& S, const Epi& E) {
    int tid_ = threadIdx.x; asm volatile("" : "+v"(tid_));
    const int tid = tid_, wid = __builtin_amdgcn_readfirstlane(tid >> 6), lane = tid & 63, wr = wid >> 2, wc = wid & 3, fr = lane & 15, fq = lane >> 4;
    const int K = g.K, nt = K / BK;
    unsigned voffA[2], voffB[2];
#pragma unroll
    for (int i = 0; i < 2; ++i) { int R, C; stage_rc(tid * 16 + i * 8192, R, C); const int Rb = Epi::PERM ? ((R & ~31) + perm32(R & 31)) : R;
        voffA[i] = (unsigned)(R * K + C) * 2u; voffB[i] = (unsigned)(Rb * K + C) * 2u; }
    const size_t kstep = (size_t)(BK * 2);
    const size_t hstep = (size_t)HALF * K * 2;
    const size_t tstep = 2 * hstep;
    const unsigned ldsw = (unsigned)wid * 1024u;
    const int aoff = lds_byte(wr * 64 + fr, fq * 8), boff = lds_byte(wc * 32 + fr, fq * 8);
#define PG8_SA(b, h) (((b) * 2 + (h)) * HTB)
#define PG8_SB(b, h) ((4 + (b) * 2 + (h)) * HTB)
#define PG8_STAGE(bufoff, gbase, voff) do { _Pragma("unroll") for (int _i = 0; _i < 2; ++_i) \
        __builtin_amdgcn_global_load_lds((const unsigned*)((const char*)(gbase) + (voff)[_i]), (PG8_LAS unsigned*)(lds + (bufoff) + ldsw + _i * 8192), 16, 0, 0); } while (0)
#define PG8_LDA(dst, b, h) do { _Pragma("unroll") for (int m = 0; m < 4; ++m) _Pragma("unroll") for (int k = 0; k < 2; ++k) dst[m][k] = *(const PG8_LAS bf16x8*)(lds + PG8_SA(b, h) + aoff + m * 2048 + k * 1024); } while (0)
#define PG8_LDB(dst, b, h) do { _Pragma("unroll") for (int n = 0; n < 2; ++n) _Pragma("unroll") for (int k = 0; k < 2; ++k) dst[n][k] = *(const PG8_LAS bf16x8*)(lds + PG8_SB(b, h) + boff + n * 2048 + k * 1024); } while (0)
#define PG8_MMA(ai, bj, At, Bt) do { __builtin_amdgcn_s_setprio(1); _Pragma("unroll") for (int m = 0; m < 4; ++m) _Pragma("unroll") for (int n = 0; n < 2; ++n) _Pragma("unroll") for (int k = 0; k < 2; ++k) \
        acc[ai][bj][m][n] = __builtin_amdgcn_mfma_f32_16x16x32_bf16(Bt[n][k], At[m][k], acc[ai][bj][m][n], 0, 0, 0); __builtin_amdgcn_s_setprio(0); } while (0)
#define PG8_WAIT_V(n) asm volatile("s_waitcnt vmcnt(" #n ")" ::: "memory")
#define PG8_WAIT_L(n) asm volatile("s_waitcnt lgkmcnt(" #n ")" ::: "memory")
#define PG8_BAR __builtin_amdgcn_s_barrier()
#define PG8_SCHED __builtin_amdgcn_sched_barrier(0)
    Unit cur, nxt; int ui = 0;
    if (!S.next(0, cur)) return;
    f32x4 acc[2][2][4][2];
#pragma unroll
    for (int a = 0; a < 2; ++a)
#pragma unroll
        for (int b = 0; b < 2; ++b)
#pragma unroll
            for (int m = 0; m < 4; ++m)
#pragma unroll
                for (int n = 0; n < 2; ++n) acc[a][b][m][n] = (f32x4){0.f, 0.f, 0.f, 0.f};
    bf16x8 At[4][2], B0[2][2], B1[2][2];
    const char* cA = (const char*)g.A + (size_t)cur.pm * tstep; const char* cB = (const char*)g.Bt + (size_t)cur.e * g.estride + (size_t)cur.pn * tstep;
    S.a_ready(cur);
    if constexpr (SP2) {
        PG8_STAGE(PG8_SB(0, 0), cB, voffB); PG8_STAGE(PG8_SB(0, 1), cB + hstep, voffB); PG8_STAGE(PG8_SA(0, 0), cA, voffA); PG8_STAGE(PG8_SA(0, 1), cA + hstep, voffA);
        if (wr == 1) PG8_BAR;
        PG8_WAIT_V(2); PG8_BAR;
        PG8_STAGE(PG8_SB(1, 0), cB + kstep, voffB); PG8_STAGE(PG8_SA(1, 0), cA + kstep, voffA); PG8_STAGE(PG8_SB(1, 1), cB + hstep + kstep, voffB);
        PG8_WAIT_V(6); PG8_BAR;
    } else {
        PG8_STAGE(PG8_SB(0, 0), cB, voffB); PG8_STAGE(PG8_SA(0, 0), cA, voffA); PG8_STAGE(PG8_SB(0, 1), cB + hstep, voffB); PG8_STAGE(PG8_SA(0, 1), cA + hstep, voffA);
        if (wr == 1) PG8_BAR;
        PG8_WAIT_V(4); PG8_BAR;
        PG8_STAGE(PG8_SB(1, 0), cB + kstep, voffB); PG8_STAGE(PG8_SA(1, 0), cA + kstep, voffA); PG8_STAGE(PG8_SB(1, 1), cB + hstep + kstep, voffB);
        PG8_WAIT_V(6); PG8_BAR;
    }
    for (;;) {
        const bool has_next = S.next(ui + 1, nxt);
        const char* nA = has_next ? (const char*)g.A + (size_t)nxt.pm * tstep : cA; const char* nB = has_next ? (const char*)g.Bt + (size_t)nxt.e * g.estride + (size_t)nxt.pn * tstep : cB;
        for (int t = 0; t < nt; t += 2) {
            const bool last = (t == nt - 2);
            const char* a1 = cA + (size_t)(t + 1) * kstep;
            const char* a2 = last ? nA : cA + (size_t)(t + 2) * kstep; const char* b2 = last ? nB : cB + (size_t)(t + 2) * kstep;
            const char* a3 = a2 + kstep; const char* b3 = b2 + kstep;
            if (last && has_next) S.a_ready(nxt);
            if constexpr (SP2) {
            PG8_LDB(B0, 0, 0); PG8_LDB(B1, 0, 1); PG8_SCHED; PG8_LDA(At, 0, 0); PG8_STAGE(PG8_SA(1, 1), a1 + hstep, voffA);
            PG8_WAIT_V(8); PG8_WAIT_L(0); PG8_BAR; PG8_MMA(0, 0, At, B0); PG8_MMA(0, 1, At, B1); PG8_BAR; PG8_SCHED;
            PG8_LDA(At, 0, 1); PG8_STAGE(PG8_SB(0, 0), b2, voffB); PG8_STAGE(PG8_SB(0, 1), b2 + hstep, voffB); PG8_STAGE(PG8_SA(0, 0), a2, voffA);
            PG8_WAIT_V(8); PG8_WAIT_L(0); PG8_BAR; PG8_MMA(1, 0, At, B0); PG8_MMA(1, 1, At, B1); PG8_BAR; PG8_SCHED;
            PG8_LDB(B0, 1, 0); PG8_LDB(B1, 1, 1); PG8_SCHED; PG8_LDA(At, 1, 0); PG8_STAGE(PG8_SA(0, 1), a2 + hstep, voffA);
            PG8_WAIT_V(8); PG8_WAIT_L(0); PG8_BAR; PG8_MMA(0, 0, At, B0); PG8_MMA(0, 1, At, B1); PG8_BAR; PG8_SCHED;
            PG8_LDA(At, 1, 1); PG8_STAGE(PG8_SB(1, 0), b3, voffB); PG8_STAGE(PG8_SB(1, 1), b3 + hstep, voffB); PG8_STAGE(PG8_SA(1, 0), a3, voffA);
            PG8_WAIT_V(8); PG8_WAIT_L(0); PG8_BAR; PG8_MMA(1, 0, At, B0); PG8_MMA(1, 1, At, B1); PG8_BAR; PG8_SCHED;
            } else {
            PG8_LDB(B0, 0, 0); PG8_SCHED; PG8_LDA(At, 0, 0); PG8_STAGE(PG8_SA(1, 1), a1 + hstep, voffA);
            PG8_WAIT_L(8); PG8_BAR; PG8_WAIT_L(0); PG8_MMA(0, 0, At, B0); PG8_BAR; PG8_SCHED;
            PG8_LDB(B1, 0, 1); PG8_STAGE(PG8_SB(0, 0), b2, voffB);
            PG8_BAR; PG8_WAIT_L(0); PG8_MMA(0, 1, At, B1); PG8_BAR;
            PG8_LDA(At, 0, 1); PG8_STAGE(PG8_SA(0, 0), a2, voffA);
            PG8_BAR; PG8_WAIT_L(0); PG8_MMA(1, 0, At, B0); PG8_BAR; PG8_SCHED;
            PG8_STAGE(PG8_SB(0, 1), b2 + hstep, voffB);
            PG8_WAIT_V(6); PG8_BAR; PG8_MMA(1, 1, At, B1); PG8_BAR;
            PG8_LDB(B0, 1, 0); PG8_SCHED; PG8_LDA(At, 1, 0); PG8_STAGE(PG8_SA(0, 1), a2 + hstep, voffA);
            PG8_WAIT_L(8); PG8_BAR; PG8_WAIT_L(0); PG8_MMA(0, 0, At, B0); PG8_BAR; PG8_SCHED;
            PG8_LDB(B1, 1, 1); PG8_STAGE(PG8_SB(1, 0), b3, voffB);
            PG8_BAR; PG8_WAIT_L(0); PG8_MMA(0, 1, At, B1); PG8_BAR;
            PG8_LDA(At, 1, 1); PG8_STAGE(PG8_SA(1, 0), a3, voffA);
            PG8_BAR; PG8_WAIT_L(0); PG8_MMA(1, 0, At, B0); PG8_BAR; PG8_SCHED;
            PG8_STAGE(PG8_SB(1, 1), b3 + hstep, voffB);
            PG8_WAIT_V(6); PG8_BAR; PG8_MMA(1, 1, At, B1); PG8_BAR;
            }
        }
        if constexpr (ALIGN_EPI) { if (wr == 0) PG8_BAR; }
        if constexpr (!Epi::AFTER_DRAIN) { E(acc, cur, wr, wc, fr, fq); S.done(cur); }
        if (!has_next) break;
#pragma unroll
        for (int a = 0; a < 2; ++a)
#pragma unroll
            for (int b = 0; b < 2; ++b)
#pragma unroll
                for (int m = 0; m < 4; ++m)
#pragma unroll
                    for (int n = 0; n < 2; ++n) acc[a][b][m][n] = (f32x4){0.f, 0.f, 0.f, 0.f};
        cur = nxt; cA = nA; cB = nB; ++ui;
        if constexpr (ALIGN_EPI) { if (wr == 1) PG8_BAR; }
    }
    PG8_WAIT_V(0);
    if constexpr (!ALIGN_EPI) { if (wr == 0) PG8_BAR; }
    PG8_BAR;
    if constexpr (Epi::AFTER_DRAIN) { E.fused(acc, cur, wr, wc, fr, fq, lds, wid, lane); S.done(cur); }
#undef PG8_SA
#undef PG8_SB
#undef PG8_STAGE
#undef PG8_LDA
#undef PG8_LDB
#undef PG8_MMA
#undef PG8_WAIT_V
#undef PG8_WAIT_L
#undef PG8_BAR
#undef PG8_SCHED
}
}
namespace pg8 {
typedef unsigned u32x2 __attribute__((ext_vector_type(2)));
constexpr int EP_NTOK = 32768;
constexpr float EP_C2 = 0.125f * 1.4426950408889634f;
__device__ __forceinline__ float sigm(float x) { return __builtin_amdgcn_rcpf(1.0f + __builtin_amdgcn_exp2f(-1.4426950408889634f * x)); }
__device__ __forceinline__ f32x4 sigm4(f32x4 v) { f32x4 o; o[0] = sigm(v[0]); o[1] = sigm(v[1]); o[2] = sigm(v[2]); o[3] = sigm(v[3]); return o; }
__device__ __forceinline__ u32x4 pack8(f32x4 v0, f32x4 v1) { u32x4 w; w.x = cvt_pk_bf16(v0[0], v0[1]); w.y = cvt_pk_bf16(v0[2], v0[3]); w.z = cvt_pk_bf16(v1[0], v1[1]); w.w = cvt_pk_bf16(v1[2], v1[3]); return w; }
__device__ __forceinline__ float bflo(unsigned u) { return __builtin_bit_cast(float, u << 16); }
__device__ __forceinline__ float bfhi(unsigned u) { return __builtin_bit_cast(float, u & 0xffff0000u); }

struct EpiInProj {
    static constexpr bool PERM = true, AFTER_DRAIN = false;
    bf16_t* proj; bf16_t* gates; const float* gate_b; const float* rope;
    __device__ __forceinline__ void operator()(const f32x4 (&acc)[2][2][4][2], const Unit& u, int wr, int wc, int fr, int fq) const {
        const int pn = u.pn; const int row0 = u.pm * BM + wr * 64 + fr;
        if (pn >= 20) {
            const int col0 = (pn - 20) * BM + wc * 32 + 8 * fq;
            f32x4 bv[2][2];
#pragma unroll
            for (int bj = 0; bj < 2; ++bj)
#pragma unroll
                for (int n = 0; n < 2; ++n) bv[bj][n] = *(const f32x4*)(gate_b + col0 + bj * HALF + 4 * n);
#pragma unroll
            for (int ai = 0; ai < 2; ++ai)
#pragma unroll
                for (int m = 0; m < 4; ++m) { bf16_t* rowp = gates + (size_t)(row0 + ai * HALF + m * 16) * 3072 + col0;
#pragma unroll
                    for (int bj = 0; bj < 2; ++bj) { const f32x4 v0 = sigm4(acc[ai][bj][m][0] + bv[bj][0]), v1 = sigm4(acc[ai][bj][m][1] + bv[bj][1]); *(u32x4*)(rowp + bj * HALF) = pack8(v0, v1); } }
        } else {
            const int t = pn >> 1; bf16_t* base = proj + (size_t)t * ((size_t)EP_NTOK * 512); const int colt = (pn & 1) * BM;
            if (t == 3 || t == 4) {
                const float sc = (t == 4) ? 0.08838834764831845f : 1.0f;
                const int hl = wc >> 1, i0 = (wc & 1) * 32 + 8 * fq;
#pragma unroll
                for (int ai = 0; ai < 2; ++ai)
#pragma unroll
                    for (int m = 0; m < 4; ++m) { const int row = row0 + ai * HALF + m * 16; const int pos = row & 2047;
                        const float* rp = rope + ((size_t)pos * 64 + i0) * 2;
                        f32x4 cs[4];
#pragma unroll
                        for (int q = 0; q < 4; ++q) cs[q] = *(const f32x4*)(rp + 4 * q);
                        f32x4 o1[2], o2[2];
#pragma unroll
                        for (int n = 0; n < 2; ++n)
#pragma unroll
                            for (int i = 0; i < 4; ++i) { const int idx = 4 * n + i; const float c = cs[idx >> 1][(idx & 1) * 2], s = cs[idx >> 1][(idx & 1) * 2 + 1];
                                const float x1 = acc[ai][0][m][n][i], x2 = acc[ai][1][m][n][i]; o1[n][i] = (x1 * c - x2 * s) * sc; o2[n][i] = (x1 * s + x2 * c) * sc; }
                        bf16_t* rowp = base + (size_t)row * 512 + colt + hl * 128 + i0;
                        *(u32x4*)(rowp) = pack8(o1[0], o1[1]); *(u32x4*)(rowp + 64) = pack8(o2[0], o2[1]); }
            } else {
                const float sc = (t == 0 || t == 7) ? EP_C2 : 1.0f; const bool silu = (t == 6);
                const int col0 = colt + wc * 32 + 8 * fq;
#pragma unroll
                for (int ai = 0; ai < 2; ++ai)
#pragma unroll
                    for (int m = 0; m < 4; ++m) { bf16_t* rowp = base + (size_t)(row0 + ai * HALF + m * 16) * 512 + col0;
#pragma unroll
                        for (int bj = 0; bj < 2; ++bj) { f32x4 v0 = acc[ai][bj][m][0], v1 = acc[ai][bj][m][1];
                            if (silu) { v0 = v0 * sigm4(v0); v1 = v1 * sigm4(v1); }
                            v0 = v0 * sc; v1 = v1 * sc; *(u32x4*)(rowp + bj * HALF) = pack8(v0, v1); } }
            }
        }
    }
};

template <int MODE> struct EpiGate {
    static constexpr bool PERM = false, AFTER_DRAIN = false;
    const bf16_t* G; float* MF; bf16_t* MB;
    __device__ __forceinline__ void operator()(const f32x4 (&acc)[2][2][4][2], const Unit& u, int wr, int wc, int fr, int fq) const {
        const int row0 = u.pm * BM + wr * 64 + fr, col0 = u.pn * BM + wc * 32 + 4 * fq;
#pragma unroll
        for (int ai = 0; ai < 2; ++ai)
#pragma unroll
            for (int m = 0; m < 4; ++m) { const size_t row = (size_t)(row0 + ai * HALF + m * 16);
#pragma unroll
                for (int bj = 0; bj < 2; ++bj)
#pragma unroll
                    for (int n = 0; n < 2; ++n) { const int c = col0 + bj * HALF + n * 16;
                        const u32x2 gw = *(const u32x2*)(G + row * 3072 + c); const f32x4 g = {bflo(gw.x), bfhi(gw.x), bflo(gw.y), bfhi(gw.y)};
                        f32x4 v = acc[ai][bj][m][n] * g; float* mp = MF + row * 1024 + c;
                        if (MODE == 0) { *(f32x4*)mp = v; }
                        else if (MODE == 1) { v += *(const f32x4*)mp; *(f32x4*)mp = v; }
                        else { v += *(const f32x4*)mp; u32x2 w; w.x = cvt_pk_bf16(v[0], v[1]); w.y = cvt_pk_bf16(v[2], v[3]); *(u32x2*)(MB + row * 1024 + c) = w; } }
                asm volatile("" ::: "memory"); }
    }
};

struct EpiResid {
    static constexpr bool PERM = false, AFTER_DRAIN = false;
    const float* XI; float* XO; const float* g1;
    __device__ __forceinline__ void operator()(const f32x4 (&acc)[2][2][4][2], const Unit& u, int wr, int wc, int fr, int fq) const {
        const int row0 = u.pm * BM + wr * 64 + fr, col0 = u.pn * BM + wc * 32 + 4 * fq; const float* gp = g1 + (size_t)(u.pm >> 3) * 6144 + col0;
        f32x4 gv[2][2];
#pragma unroll
        for (int bj = 0; bj < 2; ++bj)
#pragma unroll
            for (int n = 0; n < 2; ++n) gv[bj][n] = *(const f32x4*)(gp + bj * HALF + n * 16);
#pragma unroll
        for (int ai = 0; ai < 2; ++ai)
#pragma unroll
            for (int m = 0; m < 4; ++m) { const size_t off = (size_t)(row0 + ai * HALF + m * 16) * 1024 + col0;
#pragma unroll
                for (int bj = 0; bj < 2; ++bj)
#pragma unroll
                    for (int n = 0; n < 2; ++n) { const f32x4 xi = *(const f32x4*)(XI + off + bj * HALF + n * 16); *(f32x4*)(XO + off + bj * HALF + n * 16) = xi + gv[bj][n] * acc[ai][bj][m][n]; }
                if (m & 1) asm volatile("" ::: "memory"); }
    }
};

struct EpiUp {
    static constexpr bool PERM = true, AFTER_DRAIN = false;
    bf16_t* ACT; const float* bup;
    __device__ __forceinline__ void operator()(const f32x4 (&acc)[2][2][4][2], const Unit& u, int wr, int wc, int fr, int fq) const {
        const int row0 = u.pm * BM + wr * 64 + fr; const float* bp = bup + (size_t)u.e * 2048 + u.pn * BM + wc * 32 + 8 * fq;
        const int col0 = u.pn * HALF + wc * 32 + 8 * fq;
        f32x4 bv[2][2];
#pragma unroll
        for (int bj = 0; bj < 2; ++bj)
#pragma unroll
            for (int n = 0; n < 2; ++n) bv[bj][n] = *(const f32x4*)(bp + bj * HALF + 4 * n);
#pragma unroll
        for (int ai = 0; ai < 2; ++ai)
#pragma unroll
            for (int m = 0; m < 4; ++m) { f32x4 o[2];
#pragma unroll
                for (int n = 0; n < 2; ++n) { const f32x4 gl = acc[ai][0][m][n] + bv[0][n], li = acc[ai][1][m][n] + bv[1][n];
#pragma unroll
                    for (int i = 0; i < 4; ++i) { const float a = __builtin_fminf(gl[i], 7.0f), l = __builtin_fminf(__builtin_fmaxf(li[i], -7.0f), 7.0f); o[n][i] = a * sigm(1.702f * a) * (l + 1.0f); } }
                *(u32x4*)(ACT + (size_t)(row0 + ai * HALF + m * 16) * 1024 + col0) = pack8(o[0], o[1]); }
    }
};

struct EpiDown {
    static constexpr bool PERM = true, AFTER_DRAIN = false;
    bf16_t* Y; const float* bdn; const int* srow; const float* roww;
    __device__ __forceinline__ void operator()(const f32x4 (&acc)[2][2][4][2], const Unit& u, int wr, int wc, int fr, int fq) const {
        const int row0 = u.pm * BM + wr * 64 + fr; const int col0 = u.pn * BM + wc * 32 + 8 * fq; const float* bp = bdn + (size_t)u.e * 1024 + col0;
        f32x4 bv[2][2];
#pragma unroll
        for (int bj = 0; bj < 2; ++bj)
#pragma unroll
            for (int n = 0; n < 2; ++n) bv[bj][n] = *(const f32x4*)(bp + bj * HALF + 4 * n);
#pragma unroll
        for (int ai = 0; ai < 2; ++ai)
#pragma unroll
            for (int m = 0; m < 4; ++m) { const int row = row0 + ai * HALF + m * 16; const int slot = srow[row]; const float w = roww[row];
                if (slot >= 0) { bf16_t* rowp = Y + (size_t)slot * 1024 + col0;
#pragma unroll
                    for (int bj = 0; bj < 2; ++bj) { const f32x4 v0 = (acc[ai][bj][m][0] + bv[bj][0]) * w, v1 = (acc[ai][bj][m][1] + bv[bj][1]) * w; *(u32x4*)(rowp + bj * HALF) = pack8(v0, v1); } } }
    }
};
}
namespace attn_body {

using bf16=__hip_bfloat16;
using bf16x8=__attribute__((ext_vector_type(8)))short;
using s16x4=__attribute__((ext_vector_type(4)))short;
using f32x16=__attribute__((ext_vector_type(16)))float;
using u32x4=__attribute__((ext_vector_type(4)))unsigned;
using f32x4_t=__attribute__((ext_vector_type(4)))float;
constexpr int D=64,PITCH=512;
constexpr int NW=8,QBLK=32,QB=QBLK*NW,KVBLK=64;
constexpr int ATTN_PITCH=PITCH, ATTN_UNIT_ROWS=QB;
__device__ __forceinline__ int crow(int r,int hi){return (r&3)+8*(r>>2)+4*hi;}
#define SBAR() __builtin_amdgcn_sched_barrier(0)
__device__ __forceinline__ void cmask(f32x16&p0,f32x16&p1,int jb,int qrel,int hi){
  const float NEG=-INFINITY; int kb=64*jb+4*hi;
  #pragma unroll
  for(int r=0;r<16;++r){int kv=kb+(r&3)+8*(r>>2); if(kv>qrel)p0[r]=NEG; if(kv+32>qrel)p1[r]=NEG;}
}

constexpr int NSLOT=3, SLOTB=8192;
constexpr int LDS_K=0, LDS_V=NSLOT*SLOTB, LDS_WS=2*NSLOT*SLOTB, LDS_OST=LDS_WS+NW*64*4, LDS_FB=LDS_OST+NW*4096, LDS_BYTES=LDS_FB+8192;
constexpr float C2=0.125f*1.4426950408889634f;
__device__ __forceinline__ void glds16(const void*gsrc,unsigned lds_dst){unsigned keep;
  asm volatile("s_mov_b32 %0, m0\n\ts_mov_b32 m0, %2\n\ts_nop 0\n\tglobal_load_lds_dwordx4 %1, off\n\ts_mov_b32 m0, %0":"=&s"(keep):"v"(gsrc),"s"(lds_dst):"memory");}
__device__ __forceinline__ float max3f(float a,float b,float c){float r;asm("v_max3_f32 %0, %1, %2, %3":"=v"(r):"v"(a),"v"(b),"v"(c));return r;}
__device__ __forceinline__ float max2f(float a,float b){float r;asm("v_max_f32_e32 %0, %1, %2":"=v"(r):"v"(a),"v"(b));return r;}
__device__ __forceinline__ float fadd_s(float a,float b){float r;asm("v_add_f32_e32 %0, %1, %2":"=v"(r):"v"(a),"v"(b));return r;}
__device__ __forceinline__ float fsub_s(float a,float b){float r;asm("v_sub_f32_e32 %0, %1, %2":"=v"(r):"v"(a),"v"(b));return r;}
typedef float f32x2_t __attribute__((ext_vector_type(2))); typedef __bf16 bf16x2_t __attribute__((ext_vector_type(2)));
__device__ __forceinline__ unsigned cvtpk_s(float lo,float hi){f32x2_t v={lo,hi};bf16x2_t b=__builtin_convertvector(v,bf16x2_t);return __builtin_bit_cast(unsigned,b);}
#define WAIT_BAR(N) asm volatile("s_waitcnt vmcnt(" #N ") lgkmcnt(0)\n\ts_barrier":::"memory")

__device__ __forceinline__ void qkt(f32x16&p0,f32x16&p1,const char*Kslot,const bf16x8*qr,const f32x16&negm,int r32,int hi){
  const char*kb=Kslot+hi*1024+r32*16;
  #pragma unroll
  for(int d0=0;d0<4;++d0){
    const bf16x8 b0=*reinterpret_cast<const bf16x8*>(kb+d0*2048);
    const bf16x8 b1=*reinterpret_cast<const bf16x8*>(kb+d0*2048+512);
    if(d0==0){p0=__builtin_amdgcn_mfma_f32_32x32x16_bf16(b0,qr[0],negm,0,0,0);p1=__builtin_amdgcn_mfma_f32_32x32x16_bf16(b1,qr[0],negm,0,0,0);}
    else{p0=__builtin_amdgcn_mfma_f32_32x32x16_bf16(b0,qr[d0],p0,0,0,0);p1=__builtin_amdgcn_mfma_f32_32x32x16_bf16(b1,qr[d0],p1,0,0,0);}}
}
__device__ __forceinline__ void qkt_acc(f32x16&p0,f32x16&p1,const char*Kslot,const bf16x8*qr,int r32,int hi){
  const char*kb=Kslot+hi*1024+r32*16;
  #pragma unroll
  for(int d0=0;d0<4;++d0){
    const bf16x8 b0=*reinterpret_cast<const bf16x8*>(kb+d0*2048);
    const bf16x8 b1=*reinterpret_cast<const bf16x8*>(kb+d0*2048+512);
    p0=__builtin_amdgcn_mfma_f32_32x32x16_bf16(b0,qr[d0],p0,0,0,0);p1=__builtin_amdgcn_mfma_f32_32x32x16_bf16(b1,qr[d0],p1,0,0,0);}
}
typedef __attribute__((address_space(3))) const char* lds_cptr;
typedef short v4i16_t __attribute__((ext_vector_type(4)));
__device__ __forceinline__ void kload8(bf16x8*kf,lds_cptr kp){
  kf[0]=*(const __attribute__((address_space(3))) bf16x8*)(kp);      kf[1]=*(const __attribute__((address_space(3))) bf16x8*)(kp+512);
  kf[2]=*(const __attribute__((address_space(3))) bf16x8*)(kp+2048); kf[3]=*(const __attribute__((address_space(3))) bf16x8*)(kp+2560);
  kf[4]=*(const __attribute__((address_space(3))) bf16x8*)(kp+4096); kf[5]=*(const __attribute__((address_space(3))) bf16x8*)(kp+4608);
  kf[6]=*(const __attribute__((address_space(3))) bf16x8*)(kp+6144); kf[7]=*(const __attribute__((address_space(3))) bf16x8*)(kp+6656);
}
__device__ __forceinline__ void kload2(bf16x8*kf,lds_cptr kp,int j){ kf[2*j]=*(const __attribute__((address_space(3))) bf16x8*)(kp+j*2048); kf[2*j+1]=*(const __attribute__((address_space(3))) bf16x8*)(kp+j*2048+512); }
__device__ __forceinline__ s16x4 vtr(lds_cptr p){ return __builtin_bit_cast(s16x4,__builtin_amdgcn_ds_read_tr16_b64_v4i16((__attribute__((address_space(3))) v4i16_t*)p)); }
__device__ __forceinline__ float rowmax(const f32x16&p0,const f32x16&p1){
  float a=max3f(p0[0],p0[1],p1[0]),b=max3f(p0[2],p0[3],p1[1]);a=max3f(a,p1[2],p1[3]);
  #pragma unroll
  for(int r=4;r<16;r+=4){a=max3f(a,p0[r],p0[r+1]);b=max3f(b,p0[r+2],p0[r+3]);a=max3f(a,p1[r],p1[r+1]);b=max3f(b,p1[r+2],p1[r+3]);}
  const float m=max2f(a,b);
  auto rr=__builtin_amdgcn_permlane32_swap(__float_as_uint(m),__float_as_uint(m),false,false);
  return max2f(__uint_as_float(rr[0]),__uint_as_float(rr[1]));
}
__device__ __forceinline__ void pv(f32x16*o,int vb,bf16x8 pa0,bf16x8 pa1,bf16x8 pa2,bf16x8 pa3){
  #pragma unroll
  for(int d0=0;d0<2;++d0){s16x4 lo[4],hi[4];
    #pragma unroll
    for(int ks=0;ks<4;++ks){
      asm volatile("ds_read_b64_tr_b16 %0,%1 offset:%c2":"=&v"(lo[ks]):"v"(vb),"i"(d0*4096+ks*1024):"memory");
      asm volatile("ds_read_b64_tr_b16 %0,%1 offset:%c2":"=&v"(hi[ks]):"v"(vb),"i"(d0*4096+ks*1024+512):"memory");}
    asm volatile("s_waitcnt lgkmcnt(0)":::"memory");SBAR();
    #define PK(k) (bf16x8){lo[k][0],lo[k][1],lo[k][2],lo[k][3],hi[k][0],hi[k][1],hi[k][2],hi[k][3]}
    o[d0]=__builtin_amdgcn_mfma_f32_32x32x16_bf16(pa0,PK(0),o[d0],0,0,0);
    o[d0]=__builtin_amdgcn_mfma_f32_32x32x16_bf16(pa1,PK(1),o[d0],0,0,0);
    o[d0]=__builtin_amdgcn_mfma_f32_32x32x16_bf16(pa2,PK(2),o[d0],0,0,0);
    o[d0]=__builtin_amdgcn_mfma_f32_32x32x16_bf16(pa3,PK(3),o[d0],0,0,0);
    #undef PK
  }
}

#ifndef ATTN_STORE16
#define ATTN_STORE16(p,v) (*(u32x4*)(p)=(v))
#endif
template<int THRL,bool FB> __device__ __forceinline__ void attn_unit(int qb,const bf16*Qh,const bf16*__restrict__ Kh,const bf16*__restrict__ Vh,bf16*Oh,int opitch,const float*fbg,char*shm){
  int tid_=threadIdx.x; asm volatile("":"+v"(tid_)); const int tid=tid_,lane=tid&63,r32=lane&31,hi=lane>>5; const int wid=__builtin_amdgcn_readfirstlane(tid>>6);
  const int q0=qb*QB;
  const bf16*Qw=Qh+(long)(q0+wid*QBLK)*PITCH;
  const lds_cptr shm3=(lds_cptr)shm;
  const unsigned lds0=(unsigned)(uintptr_t)shm;
  float*wsf=(float*)(shm+LDS_WS)+wid*64;
  const bf16*ksrc=Kh+(long)lane*PITCH+wid*8;
  const bf16*vsrc=Vh+(long)(16*(wid&3)+(lane>>2))*PITCH+(wid>>2)*32+(lane&3)*8;
  const unsigned kdst=lds0+LDS_K+wid*1024, vdst=lds0+LDS_V+wid*1024;
  #define DMA_K(t,slot) glds16(ksrc+(long)(t)*KVBLK*PITCH,(unsigned)__builtin_amdgcn_readfirstlane(kdst+(slot)))
  #define DMA_V(t,slot) glds16(vsrc+(long)(t)*KVBLK*PITCH,(unsigned)__builtin_amdgcn_readfirstlane(vdst+(slot)))
  const int vb0=(int)(lds0+LDS_V)+((lane>>4)&1)*32+(lane&3)*8+(4*hi+((lane&15)>>2))*64;
  const char*Kbase=shm+LDS_K; bf16x8 kf[8];
  const lds_cptr kp0=shm3+LDS_K+hi*1024+r32*16; const lds_cptr vp0=shm3+LDS_V+((lane>>4)&1)*32+(lane&3)*8+(4*hi+((lane&15)>>2))*64;
  const int NT=(q0+QB)/KVBLK;
  typedef __attribute__((address_space(3))) float* lds_fptr; typedef __attribute__((address_space(3))) const f32x4_t* lds_f4cptr;
  if(FB){ lds_fptr fbw=(lds_fptr)(shm3+LDS_FB); for(int i=tid;i<q0+QB;i+=NW*64) fbw[i]=fbg[i]; }
  const lds_cptr fbp=shm3+LDS_FB+16*hi;
  #define FBINIT(P0,P1,t) do{ if(FB){ _Pragma("unroll") for(int g_=0;g_<4;++g_){ const f32x4_t a_=*(lds_f4cptr)(fbp+(t)*256+g_*32); const f32x4_t b_=*(lds_f4cptr)(fbp+(t)*256+128+g_*32); \
      P0[4*g_]=a_[0]-mhat;P0[4*g_+1]=a_[1]-mhat;P0[4*g_+2]=a_[2]-mhat;P0[4*g_+3]=a_[3]-mhat; P1[4*g_]=b_[0]-mhat;P1[4*g_+1]=b_[1]-mhat;P1[4*g_+2]=b_[2]-mhat;P1[4*g_+3]=b_[3]-mhat; } } }while(0)
  DMA_K(0,0);DMA_V(0,0);DMA_K(1,SLOTB);
  bf16x8 qr[4];
  #pragma unroll
  for(int d0=0;d0<4;++d0)qr[d0]=*reinterpret_cast<const bf16x8*>(&Qw[(long)r32*PITCH+d0*16+hi*8]);
  float mhat=0.f,l_reg=0.f;f32x16 o[2];o[0]=f32x16{};o[1]=f32x16{};f32x16 negm=f32x16{};if(!FB)asm volatile("":"+v"(negm));
  const int qrel=wid*QBLK+r32;
  #define CMASK(P0,P1,t) do{int jb_=(t)-(NT-4); if(jb_>=0)cmask(P0,P1,jb_,qrel,hi);}while(0)
  bool resc=false;
  #define START(P0,P1) do{ const float rm=rowmax(P0,P1); resc=false; \
    { const float dl=rm; mhat=fadd_s(mhat,dl); \
      _Pragma("unroll") for(int r=0;r<16;++r){P0[r]=fsub_s(P0[r],dl);P1[r]=fsub_s(P1[r],dl);} \
      if(!FB){ _Pragma("unroll") for(int r=0;r<16;++r)negm[r]=-mhat; asm volatile("":"+v"(negm)); } } \
    _Pragma("unroll") for(int r=0;r<16;++r)P0[r]=__builtin_amdgcn_exp2f(P0[r]); }while(0)
  #define RESC() do{ if(resc){ asm volatile("s_waitcnt lgkmcnt(0)":::"memory"); \
      _Pragma("unroll") for(int d_=0;d_<2;++d_) _Pragma("unroll") for(int r=0;r<16;++r)o[d_][r]*=wsf[crow(r,hi)]; } }while(0)
  f32x16 pA0,pA1,pB0,pB1;
  int sl_prev=0,sl_cur=0,sl_next=SLOTB;
  #define ROT() do{sl_prev=sl_cur;sl_cur=sl_next;sl_next=(sl_next==(NSLOT-1)*SLOTB)?0:sl_next+SLOTB;}while(0)
  DMA_K(2,2*SLOTB);
  WAIT_BAR(3);
  if(FB){ FBINIT(pA0,pA1,0); qkt_acc(pA0,pA1,Kbase,qr,r32,hi); } else qkt(pA0,pA1,Kbase,qr,negm,r32,hi);
  asm volatile("s_nop 15\n\ts_nop 7":"+v"(pA0),"+v"(pA1));CMASK(pA0,pA1,0);
  START(pA0,pA1);
  _Pragma("unroll") for(int r=0;r<16;++r)pA1[r]=__builtin_amdgcn_exp2f(pA1[r]);
  WAIT_BAR(0);
  DMA_K(3,0);DMA_V(1,SLOTB);
  ROT();
  kload8(kf,kp0+sl_cur);
  WAIT_BAR(2);
  s16x4 vlo[8],vhi[8]; u32x4 pw0,pw1,pw2,pw3;
  #define PKW(P,B) cvtpk_s(P[B],P[B+1])
  #define PAF(k) __builtin_bit_cast(bf16x8,pw##k)
  #define VFR(i) (bf16x8){vlo[i][0],vlo[i][1],vlo[i][2],vlo[i][3],vhi[i][0],vhi[i][1],vhi[i][2],vhi[i][3]}
  #define PIN(x) asm volatile("":"+v"(x))
  #define MX3(a,b,c) __builtin_fmaxf(__builtin_fmaxf((a),(b)),(c))
  #define GAPA(MF,A0,A1,A2,A3,W0,W1,PW) do{ MF; sacc+=A0; sacc+=A1; sacc+=A2; sacc+=A3; PIN(sacc); W0; W1; PIN(PW); SBAR(); }while(0)
  #define EX(v) __builtin_amdgcn_exp2f(v)
  #define GAPB(MF,X,B) do{ MF; X[B]=EX(X[B]); X[B+1]=EX(X[B+1]); X[B+2]=EX(X[B+2]); X[B+3]=EX(X[B+3]); PIN(X); SBAR(); }while(0)
  #define VRD(i) do{ vlo[i]=vtr(vp_+(((i)>>2)*4096+((i)&3)*1024)); vhi[i]=vtr(vp_+(((i)>>2)*4096+((i)&3)*1024+512)); }while(0)
  #define KRD(G,j) do{ if(G){ kload2(kf,kp0+sl_next,j); SBAR(); } }while(0)
  #define STEP(C0,C1,P0,P1,t,GK,GV,GL) do{ FBINIT(C0,C1,t); SBAR(); \
    const lds_cptr vp_=vp0+sl_prev; \
    VRD(0); SBAR(); float sacc=(P0[0]+P0[1]); \
    GAPA(C0=__builtin_amdgcn_mfma_f32_32x32x16_bf16(kf[0],qr[0],(FB?C0:negm),0,0,0), P0[2],P0[3],P0[4],P0[5],     pw0[0]=PKW(P0,0), pw0[1]=PKW(P0,2), pw0); \
    VRD(4); SBAR(); GAPA(C1=__builtin_amdgcn_mfma_f32_32x32x16_bf16(kf[1],qr[0],(FB?C1:negm),0,0,0), P0[6],P0[7],P0[8],P0[9],     pw0[2]=PKW(P0,4), pw0[3]=PKW(P0,6), pw0); \
    VRD(1); SBAR(); GAPA(C0=__builtin_amdgcn_mfma_f32_32x32x16_bf16(kf[2],qr[1],C0,0,0,0),   P0[10],P0[11],P0[12],P0[13], pw1[0]=PKW(P0,8), pw1[1]=PKW(P0,10), pw1); \
    VRD(5); SBAR(); GAPA(C1=__builtin_amdgcn_mfma_f32_32x32x16_bf16(kf[3],qr[1],C1,0,0,0),   P0[14],P0[15],P1[0],P1[1],   pw1[2]=PKW(P0,12),pw1[3]=PKW(P0,14), pw1); \
    VRD(2); SBAR(); GAPA(C0=__builtin_amdgcn_mfma_f32_32x32x16_bf16(kf[4],qr[2],C0,0,0,0),   P1[2],P1[3],P1[4],P1[5],     pw2[0]=PKW(P1,0), pw2[1]=PKW(P1,2), pw2); \
    VRD(6); SBAR(); GAPA(C1=__builtin_amdgcn_mfma_f32_32x32x16_bf16(kf[5],qr[2],C1,0,0,0),   P1[6],P1[7],P1[8],P1[9],     pw2[2]=PKW(P1,4), pw2[3]=PKW(P1,6), pw2); \
    VRD(3); SBAR(); GAPA(C0=__builtin_amdgcn_mfma_f32_32x32x16_bf16(kf[6],qr[3],C0,0,0,0),   P1[10],P1[11],P1[12],P1[13], pw3[0]=PKW(P1,8), pw3[1]=PKW(P1,10), pw3); \
    VRD(7); SBAR(); GAPA(C1=__builtin_amdgcn_mfma_f32_32x32x16_bf16(kf[7],qr[3],C1,0,0,0),   P1[14],P1[15],0.f,0.f,       pw3[2]=PKW(P1,12),pw3[3]=PKW(P1,14), pw3); \
    l_reg+=sacc; \
    if(GK){DMA_K((t)+3,sl_cur);} if(GV){DMA_V((t)+1,sl_next);} \
    CMASK(C0,C1,t); \
    { float a=MX3(C0[0],C0[1],C1[0]),b=MX3(C0[2],C0[3],C1[1]); a=MX3(a,C1[2],C1[3]); \
      _Pragma("unroll") for(int r=4;r<16;r+=4){a=MX3(a,C0[r],C0[r+1]);b=MX3(b,C0[r+2],C0[r+3]);a=MX3(a,C1[r],C1[r+1]);b=MX3(b,C1[r+2],C1[r+3]);} \
      float rm=__builtin_fmaxf(a,b); { auto rr=__builtin_amdgcn_permlane32_swap(__float_as_uint(rm),__float_as_uint(rm),false,false); rm=__builtin_fmaxf(__uint_as_float(rr[0]),__uint_as_float(rr[1])); } \
      resc=false; \
      if(__builtin_expect(__any(rm>(float)THRL),0)){ const float dl=__builtin_fmaxf(rm,0.f); mhat+=dl; \
        _Pragma("unroll") for(int r=0;r<16;++r){C0[r]-=dl;C1[r]-=dl;} \
        if(!FB){ _Pragma("unroll") for(int r=0;r<16;++r)negm[r]=-mhat; asm volatile("":"+v"(negm)); } \
        const float f=__builtin_amdgcn_exp2f(-dl); l_reg*=f; if(hi==0)wsf[r32]=f; resc=true; } } \
    SBAR(); \
    GAPB(o[0]=__builtin_amdgcn_mfma_f32_32x32x16_bf16(PAF(0),VFR(0),o[0],0,0,0), C0,0); \
    GAPB(o[1]=__builtin_amdgcn_mfma_f32_32x32x16_bf16(PAF(0),VFR(4),o[1],0,0,0), C0,4); \
    KRD(GL,0); GAPB(o[0]=__builtin_amdgcn_mfma_f32_32x32x16_bf16(PAF(1),VFR(1),o[0],0,0,0), C0,8); \
    KRD(GL,1); GAPB(o[1]=__builtin_amdgcn_mfma_f32_32x32x16_bf16(PAF(1),VFR(5),o[1],0,0,0), C0,12); \
    KRD(GL,2); GAPB(o[0]=__builtin_amdgcn_mfma_f32_32x32x16_bf16(PAF(2),VFR(2),o[0],0,0,0), C1,0); \
    KRD(GL,3); GAPB(o[1]=__builtin_amdgcn_mfma_f32_32x32x16_bf16(PAF(2),VFR(6),o[1],0,0,0), C1,4); \
    GAPB(o[0]=__builtin_amdgcn_mfma_f32_32x32x16_bf16(PAF(3),VFR(3),o[0],0,0,0), C1,8); \
    GAPB(o[1]=__builtin_amdgcn_mfma_f32_32x32x16_bf16(PAF(3),VFR(7),o[1],0,0,0), C1,12); \
    }while(0)
  int t=1;
  #undef CMASK
  #define CMASK(P0,P1,t) do{}while(0)
  for(;t+5<NT;t+=2){
    STEP(pB0,pB1,pA0,pA1,t,true,true,true);     WAIT_BAR(2); RESC(); ROT();
    STEP(pA0,pA1,pB0,pB1,t+1,true,true,true);   WAIT_BAR(2); RESC(); ROT();
  }
  #undef CMASK
  #define CMASK(P0,P1,t) do{int jb_=(t)-(NT-4); if(jb_>=0)cmask(P0,P1,jb_,qrel,hi);}while(0)
  #define ENDW(tt) do{ if((tt)+3<NT){WAIT_BAR(2);} else if((tt)+2<NT){WAIT_BAR(1);} else {WAIT_BAR(0);} }while(0)
  for(;t+1<NT;t+=2){
    STEP(pB0,pB1,pA0,pA1,t,(t+3<NT),(t+1<NT),(t+1<NT));       ENDW(t);   RESC(); ROT();
    STEP(pA0,pA1,pB0,pB1,t+1,(t+4<NT),(t+2<NT),(t+2<NT));     ENDW(t+1); RESC(); ROT();
  }
  STEP(pB0,pB1,pA0,pA1,NT-1,false,false,false); RESC();
  { float sacc=pB0[0]+pB0[1]; _Pragma("unroll") for(int r=2;r<16;++r)sacc+=pB0[r]; _Pragma("unroll") for(int r=0;r<16;++r)sacc+=pB1[r]; l_reg+=sacc;
    pw0=(u32x4){PKW(pB0,0),PKW(pB0,2),PKW(pB0,4),PKW(pB0,6)};pw1=(u32x4){PKW(pB0,8),PKW(pB0,10),PKW(pB0,12),PKW(pB0,14)};pw2=(u32x4){PKW(pB1,0),PKW(pB1,2),PKW(pB1,4),PKW(pB1,6)};pw3=(u32x4){PKW(pB1,8),PKW(pB1,10),PKW(pB1,12),PKW(pB1,14)};
    SBAR(); pv(o,vb0+sl_cur,PAF(0),PAF(1),PAF(2),PAF(3)); }
  #undef PKW
  #undef PAF
  #undef VFR
  #undef PIN
  #undef MX3
  #undef GAPA
  #undef GAPB
  #undef EX
  #undef VRD
  #undef KRD
  #undef STEP
  #undef ENDW
  {auto rr=__builtin_amdgcn_permlane32_swap(__float_as_uint(l_reg),__float_as_uint(l_reg),false,false);l_reg=__uint_as_float(rr[0])+__uint_as_float(rr[1]);}
  if(hi==0)wsf[32+r32]=l_reg;asm volatile("s_waitcnt lgkmcnt(0)":::"memory");
  float rli[16];
  #pragma unroll
  for(int r=0;r<16;++r)rli[r]=__builtin_amdgcn_rcpf(wsf[32+crow(r,hi)]);
  bf16*Ow=Oh+(long)(q0+wid*QBLK)*opitch;
  { bf16*stg=(bf16*)(shm+LDS_OST)+wid*2048;
    #pragma unroll
    for(int r=0;r<16;++r){const int orow=crow(r,hi);
      #pragma unroll
      for(int d0=0;d0<2;++d0)stg[orow*64+d0*32+r32]=__float2bfloat16(o[d0][r]*rli[r]);}
    asm volatile("s_waitcnt lgkmcnt(0)":::"memory");
    #pragma unroll
    for(int i=0;i<4;++i){const int row=i*8+(lane>>3),ch=lane&7; const u32x4 v=*(const u32x4*)(stg+row*64+ch*8); ATTN_STORE16(Ow+(long)row*opitch+ch*8,v);} }
  asm volatile("s_waitcnt lgkmcnt(0)\n\ts_barrier":::"memory");
  #undef DMA_K
  #undef DMA_V
  #undef CMASK
  #undef START
  #undef RESC
  #undef ROT
  #undef FBINIT
}
constexpr int ATTN_LDS_BYTES=LDS_BYTES;
#undef SBAR
#undef WAIT_BAR
}
namespace ret_body {
using bf16 = __hip_bfloat16;
using bf16x8 = __attribute__((ext_vector_type(8))) short;
using s16x4 = __attribute__((ext_vector_type(4))) short;
using f32x16 = __attribute__((ext_vector_type(16))) float;
using u32x4 = __attribute__((ext_vector_type(4))) unsigned;
typedef __attribute__((address_space(3))) const char* lds_cptr;
typedef short v4i16_t __attribute__((ext_vector_type(4)));
constexpr int PITCH = 512, QB = 256, KVBLK = 64, SLOT = 16384, LDS_K = 0, LDS_V = 2 * SLOT, LDS_BYTES = 4 * SLOT;
__device__ __forceinline__ int crow(int r, int hi) { return (r & 3) + 8 * (r >> 2) + 4 * hi; }
__device__ __forceinline__ unsigned cvtpk(float lo, float hi) { typedef float f2 __attribute__((ext_vector_type(2))); typedef __bf16 b2 __attribute__((ext_vector_type(2))); f2 v = {lo, hi}; b2 b = __builtin_convertvector(v, b2); return __builtin_bit_cast(unsigned, b); }
__device__ __forceinline__ s16x4 vtr(lds_cptr p) { return __builtin_bit_cast(s16x4, __builtin_amdgcn_ds_read_tr16_b64_v4i16((__attribute__((address_space(3))) v4i16_t*)p)); }
__device__ __forceinline__ float half_sum(float v) { v += __shfl_xor(v, 1); v += __shfl_xor(v, 2); v += __shfl_xor(v, 4); v += __shfl_xor(v, 8); v += __shfl_xor(v, 16); return v; }

__device__ __forceinline__ void ret_unit(int qb, const bf16* Qh, const bf16* __restrict__ Kh, const bf16* __restrict__ Vh, const bf16* __restrict__ Gh, bf16* Oh, float lg2, __attribute__((address_space(3))) unsigned char* shm) {
    int tid_ = threadIdx.x; asm volatile("" : "+v"(tid_)); const int tid = tid_, lane = tid & 63, r32 = lane & 31, hi = lane >> 5; const int wid = __builtin_amdgcn_readfirstlane(tid >> 6);
    const int q0 = qb * QB; const int NT = (q0 + QB) / KVBLK;
    const bf16* Qw = Qh + (long)(q0 + wid * 32) * PITCH;
    const bf16* ksrc = Kh + (long)lane * PITCH + wid * 8;
    const bf16* vsrc0 = Vh + (long)(16 * (wid & 3) + (lane >> 2)) * PITCH + (wid >> 2) * 32 + (lane & 3) * 8;
    const bf16* vsrc1 = vsrc0 + 64;
#define RET_LOAD(t, s) do { const long go_ = (long)(t) * KVBLK * PITCH; \
        __builtin_amdgcn_global_load_lds((const unsigned*)(ksrc + go_), (__attribute__((address_space(3))) unsigned*)(shm + LDS_K + (s) * SLOT + wid * 1024), 16, 0, 0); \
        __builtin_amdgcn_global_load_lds((const unsigned*)(ksrc + go_ + 64), (__attribute__((address_space(3))) unsigned*)(shm + LDS_K + (s) * SLOT + (wid + 8) * 1024), 16, 0, 0); \
        __builtin_amdgcn_global_load_lds((const unsigned*)(vsrc0 + go_), (__attribute__((address_space(3))) unsigned*)(shm + LDS_V + (s) * SLOT + wid * 1024), 16, 0, 0); \
        __builtin_amdgcn_global_load_lds((const unsigned*)(vsrc1 + go_), (__attribute__((address_space(3))) unsigned*)(shm + LDS_V + (s) * SLOT + 8192 + wid * 1024), 16, 0, 0); } while (0)
    RET_LOAD(0, 0);
    bf16x8 qr[8];
#pragma unroll
    for (int d0 = 0; d0 < 8; ++d0) qr[d0] = *reinterpret_cast<const bf16x8*>(&Qw[(long)r32 * PITCH + d0 * 16 + hi * 8]);
    f32x16 o[4];
#pragma unroll
    for (int d = 0; d < 4; ++d) o[d] = f32x16{};
    const float tq = (float)(q0 + wid * 32 + r32);
    const int kvl = (int)((lane >> 4) & 1) * 32 + (lane & 3) * 8 + (4 * hi + ((lane & 15) >> 2)) * 64;
    for (int t = 0; t < NT; ++t) {
        asm volatile("s_waitcnt vmcnt(0)" ::: "memory");
        __syncthreads();
        if (t + 1 < NT) RET_LOAD(t + 1, (t + 1) & 1);
        const lds_cptr Ks = (lds_cptr)(shm + LDS_K + (t & 1) * SLOT), Vs = (lds_cptr)(shm + LDS_V + (t & 1) * SLOT);
        f32x16 p0 = f32x16{}, p1 = f32x16{};
#pragma unroll
        for (int d0 = 0; d0 < 8; ++d0) {
            const bf16x8 k0 = *(const __attribute__((address_space(3))) bf16x8*)(Ks + (2 * d0 + hi) * 1024 + r32 * 16);
            const bf16x8 k1 = *(const __attribute__((address_space(3))) bf16x8*)(Ks + (2 * d0 + hi) * 1024 + 512 + r32 * 16);
            p0 = __builtin_amdgcn_mfma_f32_32x32x16_bf16(k0, qr[d0], p0, 0, 0, 0);
            p1 = __builtin_amdgcn_mfma_f32_32x32x16_bf16(k1, qr[d0], p1, 0, 0, 0);
        }
        const float dbase = tq - (float)(64 * t + 4 * hi);
#pragma unroll
        for (int r = 0; r < 16; ++r) {
            const float d0 = dbase - (float)((r & 3) + 8 * (r >> 2)), d1 = d0 - 32.0f;
            p0[r] = d0 >= 0.f ? p0[r] * __builtin_amdgcn_exp2f(lg2 * d0) : 0.f;
            p1[r] = d1 >= 0.f ? p1[r] * __builtin_amdgcn_exp2f(lg2 * d1) : 0.f;
        }
        u32x4 pw[4];
#pragma unroll
        for (int j = 0; j < 4; ++j) { pw[0][j] = cvtpk(p0[2 * j], p0[2 * j + 1]); pw[1][j] = cvtpk(p0[8 + 2 * j], p0[8 + 2 * j + 1]); pw[2][j] = cvtpk(p1[2 * j], p1[2 * j + 1]); pw[3][j] = cvtpk(p1[8 + 2 * j], p1[8 + 2 * j + 1]); }
#pragma unroll
        for (int d = 0; d < 4; ++d)
#pragma unroll
            for (int ks = 0; ks < 4; ++ks) {
                const s16x4 lo = vtr(Vs + d * 4096 + ks * 1024 + kvl), hh = vtr(Vs + d * 4096 + ks * 1024 + 512 + kvl);
                const bf16x8 vf = (bf16x8){lo[0], lo[1], lo[2], lo[3], hh[0], hh[1], hh[2], hh[3]};
                o[d] = __builtin_amdgcn_mfma_f32_32x32x16_bf16(__builtin_bit_cast(bf16x8, pw[ks]), vf, o[d], 0, 0, 0);
            }
    }
#undef RET_LOAD
    const long rbase = (long)(q0 + wid * 32);
#pragma unroll
    for (int r = 0; r < 16; ++r) {
        const float s = half_sum((o[0][r] + o[1][r]) + (o[2][r] + o[3][r])); const float mu = s * (1.0f / 128.0f);
        float q = 0.f;
#pragma unroll
        for (int d = 0; d < 4; ++d) { const float e = o[d][r] - mu; q += e * e; }
        q = half_sum(q); const float rstd = 1.0f / sqrtf(q * (1.0f / 128.0f) + 1e-5f);
        const long ro = (rbase + crow(r, hi)) * PITCH;
#pragma unroll
        for (int d = 0; d < 4; ++d) { const float g = __bfloat162float(Gh[ro + 32 * d + r32]); Oh[ro + 32 * d + r32] = __float2bfloat16((o[d][r] - mu) * rstd * g); }
    }
    __syncthreads();
}
}
constexpr int NWAVES = 8;
#ifndef MK_N_LAUNCHES
#define MK_N_LAUNCHES 1
#endif
constexpr int NB = 16, SEQ = 2048, DM = 1024, NTOK = NB * SEQ, DEPTH = 2;
constexpr int IN_COLS = 8200, NE = 32, TOPK = 4;
constexpr int NSLOT = NTOK * TOPK, MAXROWS = NSLOT + NE * 256, MAXTILES = MAXROWS / 256;
constexpr float NORM_EPS = 1e-5f, LOG2E = 1.4426950408889634f;
constexpr int PH_PER_LAYER = 10, N_PHASES = 2 + DEPTH * PH_PER_LAYER;
constexpr int N_LAUNCHES = (MK_N_LAUNCHES == 1) ? 1 : N_PHASES;
constexpr size_t MiB = 1u << 20;
constexpr size_t WS_CTL = 0, CTL_ZERO_BYTES = 1 * MiB;
constexpr size_t WS_MOD = 1 * MiB, WS_ROPE = 2 * MiB, WS_BUP = 3 * MiB, WS_LOGF = 4 * MiB, WS_FB = 5 * MiB;
constexpr size_t WS_SLOT_E = 11 * MiB, WS_SLOT_LP = 11 * MiB + 512 * 1024, WS_TOPW = 12 * MiB, WS_LCNT = 12 * MiB + 512 * 1024, WS_OFFS = WS_LCNT + 64 * 1024, WS_TILE_E = WS_OFFS + 4096;
constexpr size_t WS_SROW = 13 * MiB, WS_ROWW = 14 * MiB;
constexpr size_t WS_WIN = 16 * MiB, WS_WBR = 48 * MiB, WS_WOUT = 54 * MiB, WS_WUP = 64 * MiB, WS_WDN = 320 * MiB;
constexpr size_t SZ_WIN = 16 * MiB, SZ_WBR = 3 * MiB, SZ_WOUT = 2 * MiB, SZ_WUP = 128 * MiB, SZ_WDN = 64 * MiB;
constexpr size_t WS_H = 448 * MiB, WS_XR = 512 * MiB;
constexpr size_t WS_PROJ = 640 * MiB, WS_GATES = 960 * MiB, WS_A12 = 1152 * MiB, WS_OBR = 1216 * MiB, WS_MF32 = 1312 * MiB, WS_MERGED = 1440 * MiB;
constexpr size_t WS_XG = 640 * MiB, WS_ACT = 912 * MiB, WS_Y = 1184 * MiB;
constexpr size_t WS_END = 1504 * MiB;
constexpr size_t SZ_T512 = (size_t)NTOK * 512 * 2;
static_assert(WS_Y + (size_t)NSLOT * 1024 * 2 <= WS_MERGED && WS_ACT + (size_t)MAXROWS * 1024 * 2 <= WS_Y && WS_XG + (size_t)MAXROWS * 1024 * 2 <= WS_ACT, "MoE overlay");
static_assert(WS_SROW + MAXROWS * 4 <= WS_ROWW && WS_ROWW + MAXROWS * 4 <= WS_WIN && WS_TILE_E + 4096 <= WS_SROW, "small tables");
constexpr int CW_TMO = 0, CW_BAR = 4096;
constexpr int RING_OFF = 0, RING_BYTES = 131072;
constexpr int LDSCTL_OFF = RING_BYTES, MISC_OFF = LDSCTL_OFF + 320;
constexpr int LDS_BYTES = 147456;
static_assert(attn_body::ATTN_LDS_BYTES <= RING_BYTES && ret_body::LDS_BYTES <= RING_BYTES, "phase LDS");

#define GAS __attribute__((address_space(1)))
#define LAS __attribute__((address_space(3)))
typedef unsigned short bf16;
typedef unsigned v4u __attribute__((ext_vector_type(4)));
typedef float f32x4 __attribute__((ext_vector_type(4)));
typedef short bf16x8 __attribute__((ext_vector_type(8)));
typedef GAS unsigned gu32;
typedef GAS unsigned long long gu64;
#define RLX_AGENT __ATOMIC_RELAXED, __HIP_MEMORY_SCOPE_AGENT
#define LDS_WAIT() asm volatile("s_waitcnt lgkmcnt(0)" ::: "memory")
#define VM_WAIT() asm volatile("s_waitcnt vmcnt(0)" ::: "memory")
__device__ __forceinline__ unsigned long long rt() { return __builtin_amdgcn_s_memrealtime(); }
__device__ __forceinline__ unsigned f2bf(float f) { unsigned u = __builtin_bit_cast(unsigned, f); return (u + 0x7fffu + ((u >> 16) & 1u)) >> 16; }
__device__ __forceinline__ unsigned pk2(float lo, float hi) { return f2bf(lo) | (f2bf(hi) << 16); }

#define XB_TMO      128
#define XB_XCNT(j)  (256  + 64 * (j))
#define XB_XSUB(j)  (1280 + 64 * (j))
#define XB_XGEN(j)  (2304 + 64 * (j))
#define XB_TOP      3328
#define XB_TOPGEN   3392
#define XCD_BAR_WORDS 3456
#define XB_SPIN_CAP (1u << 18)

__device__ __forceinline__ unsigned xb_ld(unsigned* p)              { return __hip_atomic_load(p, __ATOMIC_RELAXED, __HIP_MEMORY_SCOPE_AGENT); }
__device__ __forceinline__ unsigned xb_add(unsigned* p, unsigned v) { return __hip_atomic_fetch_add(p, v, __ATOMIC_RELAXED, __HIP_MEMORY_SCOPE_AGENT); }
__device__ __forceinline__ unsigned xb_xcc_id() { return (unsigned)__builtin_amdgcn_s_getreg((3 << 11) | 20) & 0xFu; }
#define XB_SPIN(cond, bar) do { unsigned _sp = 0; while (cond) { __builtin_amdgcn_s_sleep(1); \
    if ((++_sp & 255u) == 0u) { if (xb_ld(&(bar)[XB_TMO])) break; if (_sp > XB_SPIN_CAP) { atomicAdd(&(bar)[XB_TMO], 1u); break; } } } } while (0)

struct XcdBarrier {
    unsigned* bar; unsigned x;
    volatile LAS unsigned* st;
};

__device__ __forceinline__ XcdBarrier xcd_barrier_post(unsigned* bar, volatile LAS unsigned* st) {
    XcdBarrier b; b.bar = bar; b.x = xb_xcc_id(); b.st = st;
    if (threadIdx.x == 0) (void)xb_add(&bar[XB_XCNT(b.x)], 1u);
    return b;
}
__device__ __forceinline__ void xcd_barrier_complete(unsigned* bar, unsigned x, unsigned& nloc, unsigned& nx) {
    const unsigned G = gridDim.x * gridDim.y * gridDim.z;
    unsigned sum, cnt, mine, sp = 0u;
    for (;;) {
        sum = 0u; cnt = 0u; mine = 0u;
#pragma unroll
        for (unsigned j = 0; j < 16; ++j) { const unsigned c = xb_ld(&bar[XB_XCNT(j)]); sum += c; cnt += (c > 0u) ? 1u : 0u; mine = (j == x) ? c : mine; }
        if (sum == G) break;
        __builtin_amdgcn_s_sleep(1);
        if ((++sp & 255u) == 0u) { if (xb_ld(&bar[XB_TMO])) break; if (sp > XB_SPIN_CAP) { atomicAdd(&bar[XB_TMO], 1u); break; } }
    }
    nloc = mine > 0u ? mine : 1u; nx = cnt > 0u ? cnt : 1u;
}

__device__ __forceinline__ void xcd_barrier(const XcdBarrier& b) {
    asm volatile("s_waitcnt vmcnt(0)" ::: "memory");
    __syncthreads();
    if (threadIdx.x == 0) {
        unsigned* bar = b.bar;
        __builtin_amdgcn_s_waitcnt(0);
        unsigned nloc = b.st[0], nx = b.st[1];
        if (nloc == 0u) { xcd_barrier_complete(bar, b.x, nloc, nx); b.st[0] = nloc; b.st[1] = nx; }
        const unsigned old = xb_add(&bar[XB_XSUB(b.x)], 1u);
        const unsigned gen = old / nloc;
        if (old + 1u == (gen + 1u) * nloc) {
            __builtin_amdgcn_fence(__ATOMIC_RELEASE, "agent");
            asm volatile("s_waitcnt vmcnt(0)" ::: "memory");
            const unsigned og = xb_add(&bar[XB_TOP], 1u);
            const unsigned tg = og / nx;
            if (og + 1u == (tg + 1u) * nx) xb_add(&bar[XB_TOPGEN], 1u);
            else XB_SPIN(xb_ld(&bar[XB_TOPGEN]) == tg, bar);
            __builtin_amdgcn_fence(__ATOMIC_ACQUIRE, "agent");
            xb_add(&bar[XB_XGEN(b.x)], 1u);
            asm volatile("s_waitcnt vmcnt(0)" ::: "memory");
        } else {
            XB_SPIN(xb_ld(&bar[XB_XGEN(b.x)]) == gen, bar);
            __builtin_amdgcn_fence(__ATOMIC_ACQUIRE, "agent");
            asm volatile("s_waitcnt vmcnt(0)" ::: "memory");
        }
    }
    __syncthreads();
}


struct Frame {
    LAS unsigned char* lds;
    volatile LAS unsigned* MISC;
    gu32* ctl;
    int tid, lane, wave, vcu, G, bx;
    unsigned char* ws;
};
constexpr int PT_OFF = LDSCTL_OFF + 1024, PT_OUT = 23, PT_WS = 24;
__device__ __forceinline__ unsigned long long ptr_ld(const Frame& F, int i) {
    const unsigned ad = (unsigned)(uintptr_t)F.lds + PT_OFF + 8 * i; unsigned tmp; unsigned long long v;
    asm volatile("v_mov_b32 %0, %2\n\tds_read_b64 %1, %0\n\ts_waitcnt lgkmcnt(0)" : "=&v"(tmp), "=v"(v) : "s"(ad) : "memory");
    const unsigned lo = __builtin_amdgcn_readfirstlane((unsigned)v), hi = __builtin_amdgcn_readfirstlane((unsigned)(v >> 32));
    return ((unsigned long long)hi << 32) | lo;
}
#define IP(i) ((const float*)(const GAS float*)ptr_ld(F, (i)))
#define WSP() ((unsigned char*)(GAS unsigned char*)ptr_ld(F, PT_WS))
__device__ __forceinline__ float wave_sum(float v) {
#pragma unroll
    for (int o = 1; o < 64; o <<= 1) v += __shfl_xor(v, o);
    return v;
}
__device__ __forceinline__ float bf_lo(unsigned u) { return __builtin_bit_cast(float, u << 16); }
__device__ __forceinline__ float bf_hi(unsigned u) { return __builtin_bit_cast(float, u & 0xffff0000u); }

struct MapId { __device__ __forceinline__ int operator()(int n) const { return n; } };
struct MapIn { __device__ __forceinline__ int operator()(int n) const {
    if (n < 1536) return n;
    if (n < 2560) { const int seg = n - 1536, p = seg >> 8, w = seg & 255, hl = w >> 7, hf = (w >> 6) & 1, i = w & 63; return 1536 + p * 256 + hf * 128 + hl * 64 + i; }
    if (n < 5120) return n;
    if (n < 5128) return -1;
    return n - 8; } };
struct MapUp { __device__ __forceinline__ int operator()(int n) const { const int j = n >> 1; return (j >> 7) * 256 + (n & 1) * 128 + (j & 127); } };
template <class Map> __device__ __forceinline__ void p0_transpose_item(const float* W, int K, int Nsrc, bf16* WT, Map map, LAS float* scr, int item, int lane) {
    const int nblk = (Nsrc + 31) / 32, kb = item / nblk, nb = item % nblk, k0 = 64 * kb, n0 = 32 * nb;
    const int nr = n0 + (lane & 31); const bool okr = nr < Nsrc;
#pragma unroll 8
    for (int i = 0; i < 32; ++i) { const int kk = 2 * i + (lane >> 5); scr[kk * 33 + (lane & 31)] = okr ? W[(size_t)(k0 + kk) * Nsrc + nr] : 0.f; }
    LDS_WAIT(); asm volatile("" ::: "memory");
    const int c = lane & 7;
#pragma unroll
    for (int j = 0; j < 4; ++j) { const int n = (lane >> 3) + 8 * j; const LAS float* s = scr + (8 * c) * 33 + n; const int dr = (n0 + n < Nsrc) ? map(n0 + n) : -1;
        v4u o; o.x = pk2(s[0 * 33], s[1 * 33]); o.y = pk2(s[2 * 33], s[3 * 33]); o.z = pk2(s[4 * 33], s[5 * 33]); o.w = pk2(s[6 * 33], s[7 * 33]);
        if (dr >= 0) *(GAS v4u*)(WT + (size_t)dr * K + k0 + 8 * c) = o; }
    LDS_WAIT(); asm volatile("" ::: "memory");
}
constexpr int IT_IN = 16 * 257, IT_BR = 3 * 8 * 32, IT_OUT = 16 * 32, IT_UP = NE * 16 * 64, IT_DN = NE * 16 * 32, IT_LAYER = IT_IN + IT_BR + IT_OUT + IT_UP + IT_DN;

struct Ins {
    const float *x, *c, *norm1_g, *norm2_g, *ada_w, *ada_b, *w_in, *gate_b, *fox_fb, *lam_q1, *lam_k1, *lam_q2, *lam_k2, *subln_g, *w_branch, *w_out, *router_w, *router_b, *w_up, *b_up, *w_down, *b_down, *final_g;
};

__device__ __forceinline__ void p0_prologue(Frame& F) {
    const int gw = F.vcu * NWAVES + F.wave, NGW = F.G * NWAVES; unsigned char* const wsl = WSP();
    {
        LAS float* sc = (LAS float*)(F.lds + RING_OFF);
        LAS float* red = (LAS float*)(F.lds + RING_OFF + 65536);
        bool filled = false;
        for (int it = F.vcu; it < DEPTH * 96; it += F.G) {
            if (!filled) { for (int idx = F.tid; idx < NB * DM; idx += NWAVES * 64) { const int b = idx >> 10, k = idx & 1023; const float v = IP(1  )[idx]; sc[k * 16 + b] = v / (1.0f + __expf(-v)); } filled = true; }
            __syncthreads();
            const int l = it / 96, cb = it % 96; const float* W = IP(4  ) + (size_t)l * DM * 6144 + cb * 64 + F.lane;
            float acc[16];
#pragma unroll
            for (int b = 0; b < 16; ++b) acc[b] = 0.f;
            for (int k = F.wave * 128; k < F.wave * 128 + 128; ++k) { const float w = W[(size_t)k * 6144];
#pragma unroll
                for (int q = 0; q < 4; ++q) { const f32x4 s4 = *(const LAS f32x4*)(sc + k * 16 + 4 * q); acc[4 * q] += s4[0] * w; acc[4 * q + 1] += s4[1] * w; acc[4 * q + 2] += s4[2] * w; acc[4 * q + 3] += s4[3] * w; } }
#pragma unroll
            for (int b = 0; b < 16; ++b) red[(F.wave * 16 + b) * 64 + F.lane] = acc[b];
            __syncthreads();
            for (int o = F.tid; o < 1024; o += NWAVES * 64) { const int b = o >> 6, col = o & 63; float s = IP(5  )[l * 6144 + cb * 64 + col];
#pragma unroll
                for (int w = 0; w < 8; ++w) s += red[(w * 16 + b) * 64 + col];
                ((float*)(wsl + WS_MOD))[(size_t)(l * 16 + b) * 6144 + cb * 64 + col] = s; }
        }
        __syncthreads();
    }
    {
        float* rope = (float*)(wsl + WS_ROPE);
        for (int idx = (F.vcu * NWAVES * 64) + F.tid; idx < SEQ * 64; idx += F.G * NWAVES * 64) { const int pos = idx >> 6, i = idx & 63;
            const float inv = (float)exp2(-(double)i * (13.287712379549449 / 64.0));
            const float ang = (float)pos * inv; const double rev = (double)ang * 0.15915494309189535; const float fr = (float)(rev - rint(rev));
            rope[2 * idx] = __builtin_amdgcn_cosf(fr); rope[2 * idx + 1] = __builtin_amdgcn_sinf(fr); }
        float* bup = (float*)(wsl + WS_BUP); MapUp mu;
        for (int idx = (F.vcu * NWAVES * 64) + F.tid; idx < DEPTH * NE * 2048; idx += F.G * NWAVES * 64) { const int n = idx & 2047, le = idx >> 11; bup[(size_t)le * 2048 + mu(n)] = IP(19  )[idx]; }
    }
    LAS float* scr = (LAS float*)(F.lds + RING_OFF + F.wave * 16384);
    for (int it = gw; it < DEPTH * IT_LAYER; it += NGW) {
        const int l = it / IT_LAYER; int r = it % IT_LAYER;
        if (r < IT_IN) { p0_transpose_item(IP(6  ) + (size_t)l * DM * IN_COLS, DM, IN_COLS, (bf16*)(wsl + WS_WIN + l * SZ_WIN), MapIn(), scr, r, F.lane); continue; } r -= IT_IN;
        if (r < IT_BR) { const int b = r / 256; p0_transpose_item(IP(14  ) + ((size_t)l * 3 + b) * 512 * DM, 512, DM, (bf16*)(wsl + WS_WBR + l * SZ_WBR) + (size_t)b * DM * 512, MapId(), scr, r % 256, F.lane); continue; } r -= IT_BR;
        if (r < IT_OUT) { p0_transpose_item(IP(15  ) + (size_t)l * DM * DM, DM, DM, (bf16*)(wsl + WS_WOUT + l * SZ_WOUT), MapId(), scr, r, F.lane); continue; } r -= IT_OUT;
        if (r < IT_UP) { const int e = r / 1024; p0_transpose_item(IP(18  ) + ((size_t)l * NE + e) * DM * 2048, DM, 2048, (bf16*)(wsl + WS_WUP + l * SZ_WUP) + (size_t)e * 2048 * DM, MapUp(), scr, r % 1024, F.lane); continue; } r -= IT_UP;
        { const int e = r / 512; p0_transpose_item(IP(20  ) + ((size_t)l * NE + e) * DM * DM, DM, DM, (bf16*)(wsl + WS_WDN + l * SZ_WDN) + (size_t)e * DM * DM, MapId(), scr, r % 512, F.lane); }
    }
}

constexpr int TL_RS = 0, TL_BP = 512, TL_PART = 4096, TL_HIST = 40960, TL_BASE = 41216, TL_ROWOF = 41472;
template <bool UPD> __device__ __forceinline__ void norm_block(Frame& F, int blk, const float* xin, float* xr, const bf16* Y, const float* g2, const float* gain, const float* modl, int i_sh, int i_sc, bf16* H) {
    LAS float* rs = (LAS float*)(F.lds + TL_RS);
    for (int r = 0; r < 16; ++r) {
        const int row = blk * 128 + F.wave * 16 + r, b = row >> 11;
        f32x4 v[4];
#pragma unroll
        for (int j = 0; j < 4; ++j) v[j] = *(const f32x4*)(xin + (size_t)row * DM + 4 * (64 * j + F.lane));
        if (UPD) {
#pragma unroll
            for (int j = 0; j < 4; ++j) { const int c = 4 * (64 * j + F.lane); f32x4 a = {0.f, 0.f, 0.f, 0.f};
#pragma unroll
                for (int k = 0; k < 4; ++k) { const uint2 y = *(const uint2*)(Y + ((size_t)row * 4 + k) * DM + c); a[0] += bf_lo(y.x); a[1] += bf_hi(y.x); a[2] += bf_lo(y.y); a[3] += bf_hi(y.y); }
                const f32x4 g = *(const f32x4*)(g2 + (size_t)b * 6144 + c); v[j] += g * a; *(f32x4*)(xr + (size_t)row * DM + c) = v[j]; }
        }
        float ss = 0.f;
#pragma unroll
        for (int j = 0; j < 4; ++j) ss += (v[j][0] * v[j][0] + v[j][1] * v[j][1]) + (v[j][2] * v[j][2] + v[j][3] * v[j][3]);
        const float rstd = 1.0f / sqrtf(wave_sum(ss) * (1.0f / DM) + NORM_EPS);
        if (F.lane == 0) rs[F.wave * 16 + r] = rstd;
#pragma unroll
        for (int j = 0; j < 4; ++j) { const int c = 4 * (64 * j + F.lane);
            const f32x4 gn = *(const f32x4*)(gain + c), sc = *(const f32x4*)(modl + (size_t)b * 6144 + i_sc * 1024 + c), sh = *(const f32x4*)(modl + (size_t)b * 6144 + i_sh * 1024 + c);
            const f32x4 h = (v[j] * rstd) * gn * (sc + 1.0f) + sh;
            uint2 o; o.x = pk2(h[0], h[1]); o.y = pk2(h[2], h[3]); *(uint2*)(H + (size_t)row * DM + c) = o; }
    }
}
__device__ __forceinline__ void proj_block(Frame& F, int blk, const float* xrows, const float* W, int wpitch, int ncols, const float* gain, const float* modl, int i_sh, int i_sc) {
    typedef float f32x16 __attribute__((ext_vector_type(16)));
    const int rb = F.wave & 3, kh2 = F.wave >> 2, i = F.lane & 31, kh = F.lane >> 5; const int b = (blk * 128) >> 11;
    const float* x0 = xrows + (size_t)(blk * 128 + rb * 32 + i) * DM; const float* scp = modl + (size_t)b * 6144 + i_sc * 1024; const float* shp = modl + (size_t)b * 6144 + i_sh * 1024;
    const bool wok = i < ncols; const float* Wc = W + (wok ? i : 0);
    f32x16 acc = {0.f, 0.f, 0.f, 0.f, 0.f, 0.f, 0.f, 0.f, 0.f, 0.f, 0.f, 0.f, 0.f, 0.f, 0.f, 0.f}; float bacc = 0.f;
    for (int c = 64 * kh2; c < 64 * kh2 + 64; ++c) { const int k0 = 8 * c + 4 * kh;
        const f32x4 a = *(const f32x4*)(x0 + k0), gn = *(const f32x4*)(gain + k0), sc = *(const f32x4*)(scp + k0), sh = *(const f32x4*)(shp + k0);
#pragma unroll
        for (int j = 0; j < 4; ++j) { const float wv = wok ? Wc[(size_t)(k0 + j) * wpitch] : 0.f; bacc += sh[j] * wv; acc = __builtin_amdgcn_mfma_f32_32x32x2f32(a[j], gn[j] * (1.0f + sc[j]) * wv, acc, 0, 0, 0); } }
    LAS float* part = (LAS float*)(F.lds + TL_PART) + F.wave * (32 * 33);
#pragma unroll
    for (int r = 0; r < 16; ++r) part[((r & 3) + 8 * (r >> 2) + 4 * kh) * 33 + i] = acc[r];
    ((LAS float*)(F.lds + TL_BP))[(F.wave * 2 + kh) * 32 + i] = bacc;
}
__device__ __forceinline__ float proj_logit(Frame& F, int t, int e) {
    const int rb = t >> 5, r = t & 31; const LAS float* part = (const LAS float*)(F.lds + TL_PART); const LAS float* bp = (const LAS float*)(F.lds + TL_BP);
    const float d = part[(rb * 32 + r) * 33 + e] + part[((rb + 4) * 32 + r) * 33 + e];
    const float bb = (bp[(rb * 2) * 32 + e] + bp[(rb * 2 + 1) * 32 + e]) + (bp[((rb + 4) * 2) * 32 + e] + bp[((rb + 4) * 2 + 1) * 32 + e]);
    return ((const LAS float*)(F.lds + TL_RS))[t] * d + bb;
}

__device__ __forceinline__ void diff_post(Frame& F, int l, float lam_init) {
    float d1 = IP(9  )[l * 64 + F.lane] * IP(10  )[l * 64 + F.lane], d2 = IP(11  )[l * 64 + F.lane] * IP(12  )[l * 64 + F.lane];
    const float lam = __expf(wave_sum(d1)) - __expf(wave_sum(d2)) + lam_init; const float osc = 1.0f - lam_init;
    unsigned char* const wsl = WSP();
    const bf16* A1 = (const bf16*)(wsl + WS_A12); const bf16* A2 = A1 + (size_t)NTOK * 512; bf16* O = (bf16*)(wsl + WS_OBR);
    const int c0 = 8 * F.lane; const float* gp = IP(13  ) + l * 128 + (c0 & 127);
    const f32x4 g0 = *(const f32x4*)gp, g1 = *(const f32x4*)(gp + 4);
    for (int row = F.vcu * NWAVES + F.wave; row < NTOK; row += F.G * NWAVES) {
        const v4u a = *(const v4u*)(A1 + (size_t)row * 512 + c0), bq = *(const v4u*)(A2 + (size_t)row * 512 + c0);
        float d[8]; const unsigned au[4] = {a.x, a.y, a.z, a.w}, bu[4] = {bq.x, bq.y, bq.z, bq.w};
#pragma unroll
        for (int q = 0; q < 4; ++q) { d[2 * q] = bf_lo(au[q]) - lam * bf_lo(bu[q]); d[2 * q + 1] = bf_hi(au[q]) - lam * bf_hi(bu[q]); }
        float ss = 0.f;
#pragma unroll
        for (int q = 0; q < 8; ++q) ss += d[q] * d[q];
        ss += __shfl_xor(ss, 1); ss += __shfl_xor(ss, 2); ss += __shfl_xor(ss, 4); ss += __shfl_xor(ss, 8);
        const float rr = osc / sqrtf(ss * (1.0f / 128.0f) + NORM_EPS);
        v4u o; o.x = pk2(d[0] * rr * g0[0], d[1] * rr * g0[1]); o.y = pk2(d[2] * rr * g0[2], d[3] * rr * g0[3]); o.z = pk2(d[4] * rr * g1[0], d[5] * rr * g1[1]); o.w = pk2(d[6] * rr * g1[2], d[7] * rr * g1[3]);
        *(v4u*)(O + (size_t)row * 512 + c0) = o;
    }
}

struct Args { Ins in; float* out; unsigned char* ws; int ph_lo, ph_hi; };
__global__ void __launch_bounds__(NWAVES * 64, 2) mega_fwd(Args args) {
    extern __shared__ __attribute__((aligned(16))) unsigned char lds[];
    Frame F;
    F.lds = (LAS unsigned char*)lds;
    F.MISC = (volatile LAS unsigned*)(F.lds + MISC_OFF);
    F.tid = threadIdx.x; F.lane = F.tid & 63; F.wave = __builtin_amdgcn_readfirstlane(F.tid >> 6);
    F.G = gridDim.x; { const int bx = blockIdx.x; F.vcu = (F.G % 8 == 0) ? (bx % 8) * (F.G / 8) + bx / 8 : bx; }
    F.ctl = (gu32*)(args.ws + WS_CTL);
    for (int u = F.tid; u < (LDS_BYTES - LDSCTL_OFF) / 4; u += NWAVES * 64) ((LAS unsigned*)(F.lds + LDSCTL_OFF))[u] = 0u;
    if (F.tid == 0) { LAS unsigned long long* pt = (LAS unsigned long long*)(F.lds + PT_OFF);
#define PTW(i, f) pt[i] = (unsigned long long)args.in.f
        PTW(0, x); PTW(1, c); PTW(2, norm1_g); PTW(3, norm2_g); PTW(4, ada_w); PTW(5, ada_b); PTW(6, w_in); PTW(7, gate_b); PTW(8, fox_fb); PTW(9, lam_q1); PTW(10, lam_k1); PTW(11, lam_q2); PTW(12, lam_k2);
        PTW(13, subln_g); PTW(14, w_branch); PTW(15, w_out); PTW(16, router_w); PTW(17, router_b); PTW(18, w_up); PTW(19, b_up); PTW(20, w_down); PTW(21, b_down); PTW(22, final_g);
#undef PTW
        pt[PT_OUT] = (unsigned long long)args.out; pt[PT_WS] = (unsigned long long)args.ws; }
    __syncthreads();
    XcdBarrier bar; bar.bar = (unsigned*)(F.ctl + CW_BAR); bar.x = 0; bar.st = nullptr;
    if (N_LAUNCHES == 1) bar = xcd_barrier_post((unsigned*)(F.ctl + CW_BAR), F.MISC + 8);
#define GRID_BAR() do { if (N_LAUNCHES == 1) { XcdBarrier b2_ = bar; asm volatile("" : "+s"(b2_.bar), "+s"(b2_.x)); xcd_barrier(b2_); } } while (0)
    const int lo = args.ph_lo, hi = args.ph_hi;
#define IN(k) (N_LAUNCHES == 1 || (lo <= (k) && (k) < hi))
#ifndef EN_MASK
#define EN_MASK 0x7fff
#endif
#define EN(b) (((EN_MASK) >> (b)) & 1)
#define SEAM(k) do { if (IN(k) && IN((k) + 1)) GRID_BAR(); } while (0)
#define PHASE_PTRS { int t_ = threadIdx.x, g_ = gridDim.x, bx_ = blockIdx.x; asm volatile("" : "+v"(t_), "+s"(g_), "+s"(bx_)); F.tid = t_; F.lane = t_ & 63; F.wave = __builtin_amdgcn_readfirstlane(t_ >> 6); F.G = g_; F.bx = bx_; F.vcu = (g_ % 8 == 0) ? (bx_ % 8) * (g_ / 8) + bx_ / 8 : bx_; } unsigned char* const ws = WSP(); float* const MOD = (float*)(ws + WS_MOD); float* const XR = (float*)(ws + WS_XR); bf16* const H = (bf16*)(ws + WS_H); bf16* const PROJ = (bf16*)(ws + WS_PROJ); \
    bf16* const GATES = (bf16*)(ws + WS_GATES); bf16* const OBR = (bf16*)(ws + WS_OBR); float* const LOGF = (float*)(ws + WS_LOGF); float* const FBT = (float*)(ws + WS_FB); \
    int* const SLOT_E = (int*)(ws + WS_SLOT_E); int* const SLOT_LP = (int*)(ws + WS_SLOT_LP); float* const TOPW = (float*)(ws + WS_TOPW); int* const LCNT = (int*)(ws + WS_LCNT); \
    int* const OFFS = (int*)(ws + WS_OFFS); int* const TILE_E = (int*)(ws + WS_TILE_E); int* const SROW = (int*)(ws + WS_SROW); float* const ROWW = (float*)(ws + WS_ROWW); \
    bf16* const XG = (bf16*)(ws + WS_XG); bf16* const ACT = (bf16*)(ws + WS_ACT); bf16* const YB = (bf16*)(ws + WS_Y); const float* const modl = MOD + (size_t)l * NB * 6144; \
    (void)XR; (void)H; (void)PROJ; (void)GATES; (void)OBR; (void)LOGF; (void)FBT; (void)SLOT_E; (void)SLOT_LP; (void)TOPW; (void)LCNT; (void)OFFS; (void)TILE_E; (void)SROW; (void)ROWW; (void)XG; (void)ACT; (void)YB; (void)modl
    if (EN(0) && IN(0)) { { int t_ = threadIdx.x, g_ = gridDim.x, bx_ = blockIdx.x; asm volatile("" : "+v"(t_), "+s"(g_), "+s"(bx_)); F.tid = t_; F.lane = t_ & 63; F.wave = __builtin_amdgcn_readfirstlane(t_ >> 6); F.G = g_; F.bx = bx_; F.vcu = (g_ % 8 == 0) ? (bx_ % 8) * (g_ / 8) + bx_ / 8 : bx_; } p0_prologue(F); }
    SEAM(0);

#ifndef DBG_LAYERS
#define DBG_LAYERS DEPTH
#endif
#ifndef DBG_SEL
#define DBG_SEL 7
#endif
#ifndef DBG_OUT
#define DBG_OUT 0
#endif
    for (int l = 0; l < DBG_LAYERS; ++l) {
        const int P = 1 + l * PH_PER_LAYER;
        const float lam_init = (l == 0) ? 0.2f : 0.35550906759096926f;
        if (EN(1) && IN(P + 0)) { PHASE_PTRS;
            for (int blk = F.vcu; blk < NTOK / 128; blk += F.G) {
                if (l == 0) norm_block<false>(F, blk, IP(0  ), nullptr, nullptr, nullptr, IP(2  ) + l * DM, modl, 0, 1, H);
                else        norm_block<true>(F, blk, XR, XR, YB, MOD + (size_t)(l - 1) * NB * 6144 + 5 * 1024, IP(2  ) + l * DM, modl, 0, 1, H);
                asm volatile("s_waitcnt vmcnt(0)" ::: "memory"); __syncthreads(); __builtin_amdgcn_fence(__ATOMIC_ACQUIRE, "agent");
                proj_block(F, blk, (l == 0) ? IP(0  ) : (const float*)XR, IP(6  ) + (size_t)l * DM * IN_COLS + 5120, IN_COLS, 8, IP(2  ) + l * DM, modl, 0, 1);
                __syncthreads();
                if (F.tid < 128) { const int row = blk * 128 + F.tid;
#pragma unroll
                    for (int e = 0; e < 8; ++e) { const float z = proj_logit(F, F.tid, e) + IP(8  )[l * 8 + e];
                        const float ls = (z >= 0.f) ? -log1pf(__expf(-z)) : (z - log1pf(__expf(z))); LOGF[(size_t)row * 8 + e] = ls; } }
                __syncthreads();
            }
        }
        SEAM(P + 0);
        if (EN(2) && IN(P + 1)) { PHASE_PTRS;
            LAS float* wtot = (LAS float*)(F.lds + MISC_OFF + 256);
            for (int j = F.vcu; j < NB * 8; j += F.G) {
                const int b = j >> 3, hh = j & 7; float v[4]; float run = 0.f;
#pragma unroll
                for (int q = 0; q < 4; ++q) { run += LOGF[((size_t)b * SEQ + 4 * F.tid + q) * 8 + hh]; v[q] = run; }
                float inc = run;
#pragma unroll
                for (int o = 1; o < 64; o <<= 1) { const float nb = __shfl_up(inc, o); if (F.lane >= o) inc += nb; }
                if (F.lane == 63) wtot[F.wave] = inc;
                __syncthreads();
                float base = inc - run;
                for (int w = 0; w < F.wave; ++w) base += wtot[w];
#pragma unroll
                for (int q = 0; q < 4; ++q) FBT[((size_t)b * 8 + hh) * SEQ + 4 * F.tid + q] = -LOG2E * (base + v[q]);
                __syncthreads();
            }
            pg8::Gemm g{(const pg8::bf16_t*)H, (const pg8::bf16_t*)(ws + WS_WIN + l * SZ_WIN), NTOK, 8192, DM, 0};
            pg8::StaticOrder S; S.init(NTOK, 8192, F.G, F.bx);
            pg8::EpiInProj E{(pg8::bf16_t*)PROJ, (pg8::bf16_t*)GATES, IP(7  ) + l * 3072, (const float*)(ws + WS_ROPE)};
            pg8::gemm_phase<pg8::EpiInProj, pg8::StaticOrder, true, true>(F.lds + RING_OFF, g, S, E);
        }
        SEAM(P + 1);
        if (EN(3) && IN(P + 2)) { PHASE_PTRS;
            using abf = attn_body::bf16;
            if (EN(12)) for (int j = F.vcu; j < NB * 8 * 4; j += F.G) { const int bh = j >> 2, s = j & 3, b = bh >> 3, hh = bh & 7; const size_t ro = (size_t)b * SEQ * 512 + hh * 64;
                const abf* Q = (const abf*)(PROJ + 7 * (size_t)NTOK * 512) + ro; const abf* K = (const abf*)(PROJ + 8 * (size_t)NTOK * 512) + ro; const abf* V = (const abf*)(PROJ + 9 * (size_t)NTOK * 512) + ro;
                abf* O = (abf*)(OBR + 2 * (size_t)NTOK * 512) + ro; const float* fb = FBT + ((size_t)b * 8 + hh) * SEQ;
                attn_body::attn_unit<8, true>(7 - s, Q, K, V, O, 512, fb, (char*)lds + RING_OFF);
                attn_body::attn_unit<8, true>(s, Q, K, V, O, 512, fb, (char*)lds + RING_OFF); }
            if (EN(13)) for (int j = F.vcu; j < NB * 16 * 4; j += F.G) { const int bv = j >> 2, s = j & 3, b = bv >> 4, v = bv & 15, h = v >> 2, m = (v >> 1) & 1, vh = v & 1; const size_t rb = (size_t)b * SEQ * 512;
                const abf* Q = (const abf*)(PROJ) + rb + h * 128 + m * 64; const abf* K = (const abf*)(PROJ + 1 * (size_t)NTOK * 512) + rb + h * 128 + m * 64; const abf* V = (const abf*)(PROJ + 2 * (size_t)NTOK * 512) + rb + h * 128 + vh * 64;
                abf* O = (abf*)(ws + WS_A12) + (size_t)m * NTOK * 512 + rb + h * 128 + vh * 64;
                attn_body::attn_unit<8, false>(7 - s, Q, K, V, O, 512, nullptr, (char*)lds + RING_OFF);
                attn_body::attn_unit<8, false>(s, Q, K, V, O, 512, nullptr, (char*)lds + RING_OFF); }
            if (EN(14)) for (int j = F.vcu; j < NB * 4 * 4; j += F.G) { const int bh = j >> 2, s = j & 3, b = bh >> 2, hh = bh & 3; const size_t ro = (size_t)b * SEQ * 512 + hh * 128;
                const abf* Q = (const abf*)(PROJ + 3 * (size_t)NTOK * 512) + ro; const abf* K = (const abf*)(PROJ + 4 * (size_t)NTOK * 512) + ro; const abf* V = (const abf*)(PROJ + 5 * (size_t)NTOK * 512) + ro;
                const abf* Gt = (const abf*)(PROJ + 6 * (size_t)NTOK * 512) + ro; abf* O = (abf*)(OBR + 1 * (size_t)NTOK * 512) + ro;
                const float lg2 = log2f(1.0f - exp2f(-5.0f - (float)hh));
                ret_body::ret_unit(7 - s, Q, K, V, Gt, O, lg2, F.lds + RING_OFF);
                ret_body::ret_unit(s, Q, K, V, Gt, O, lg2, F.lds + RING_OFF); }
        }
        SEAM(P + 2);
        if (EN(4) && IN(P + 3)) { PHASE_PTRS; diff_post(F, l, lam_init); }
        SEAM(P + 3);
        if (EN(5) && IN(P + 4)) { PHASE_PTRS;
            const pg8::bf16_t* WB = (const pg8::bf16_t*)(ws + WS_WBR + l * SZ_WBR);
            pg8::StaticOrder S; S.init(NTOK, DM, F.G, F.bx);
            { pg8::Gemm g{(const pg8::bf16_t*)OBR, WB, NTOK, DM, 512, 0}; pg8::EpiGate<0> E{(const pg8::bf16_t*)GATES, (float*)(ws + WS_MF32), (pg8::bf16_t*)(ws + WS_MERGED)};
              pg8::gemm_phase<pg8::EpiGate<0>, pg8::StaticOrder, true, true>(F.lds + RING_OFF, g, S, E); }
            __builtin_amdgcn_fence(__ATOMIC_ACQUIRE, "agent");
            { pg8::Gemm g{(const pg8::bf16_t*)OBR + (size_t)NTOK * 512, WB + (size_t)DM * 512, NTOK, DM, 512, 0}; pg8::EpiGate<1> E{(const pg8::bf16_t*)GATES + 1024, (float*)(ws + WS_MF32), (pg8::bf16_t*)(ws + WS_MERGED)};
              pg8::gemm_phase<pg8::EpiGate<1>, pg8::StaticOrder, true, true>(F.lds + RING_OFF, g, S, E); }
            __builtin_amdgcn_fence(__ATOMIC_ACQUIRE, "agent");
            { pg8::Gemm g{(const pg8::bf16_t*)OBR + 2 * (size_t)NTOK * 512, WB + 2 * (size_t)DM * 512, NTOK, DM, 512, 0}; pg8::EpiGate<2> E{(const pg8::bf16_t*)GATES + 2048, (float*)(ws + WS_MF32), (pg8::bf16_t*)(ws + WS_MERGED)};
              pg8::gemm_phase<pg8::EpiGate<2>, pg8::StaticOrder, true, true>(F.lds + RING_OFF, g, S, E); }
        }
        SEAM(P + 4);
        if (EN(6) && IN(P + 5)) { PHASE_PTRS;
            pg8::Gemm g{(const pg8::bf16_t*)(ws + WS_MERGED), (const pg8::bf16_t*)(ws + WS_WOUT + l * SZ_WOUT), NTOK, DM, DM, 0};
            pg8::StaticOrder S; S.init(NTOK, DM, F.G, F.bx);
            pg8::EpiResid E{(l == 0) ? IP(0  ) : (const float*)XR, XR, modl + 2 * 1024};
            pg8::gemm_phase<pg8::EpiResid, pg8::StaticOrder, true, true>(F.lds + RING_OFF, g, S, E);
        }
        SEAM(P + 5);
        if (EN(7) && IN(P + 6)) { PHASE_PTRS;
            LAS int* hist = (LAS int*)(F.lds + TL_HIST);
            for (int blk = F.vcu; blk < NTOK / 128; blk += F.G) {
                if (F.tid < 32) hist[F.tid] = 0;
                norm_block<false>(F, blk, XR, nullptr, nullptr, nullptr, IP(3  ) + l * DM, modl, 3, 4, H);
                __syncthreads();
                proj_block(F, blk, XR, IP(16  ) + (size_t)l * DM * NE, NE, NE, IP(3  ) + l * DM, modl, 3, 4);
                __syncthreads();
                if (F.tid < 128) { const int row = blk * 128 + F.tid;
                    float lg[32];
#pragma unroll
                    for (int e = 0; e < 32; ++e) lg[e] = proj_logit(F, F.tid, e) + IP(17  )[l * NE + e];
                    int be[4]; float bvv[4];
#pragma unroll
                    for (int k = 0; k < 4; ++k) { float best = -INFINITY; int bi = 0;
#pragma unroll
                        for (int e = 0; e < 32; ++e) { const bool take = lg[e] > best; best = take ? lg[e] : best; bi = take ? e : bi; }
                        be[k] = bi; bvv[k] = best;
#pragma unroll
                        for (int e = 0; e < 32; ++e) lg[e] = (e == bi) ? -INFINITY : lg[e]; }
                    const float e1 = __expf(bvv[1] - bvv[0]), e2 = __expf(bvv[2] - bvv[0]), e3 = __expf(bvv[3] - bvv[0]); const float inv = 1.0f / (1.0f + e1 + e2 + e3);
                    const float wk[4] = {inv, e1 * inv, e2 * inv, e3 * inv};
#pragma unroll
                    for (int k = 0; k < 4; ++k) { const int slot = row * 4 + k; const int lp = atomicAdd((int*)(hist + be[k]), 1); SLOT_E[slot] = be[k]; SLOT_LP[slot] = lp; TOPW[slot] = wk[k]; } }
                __syncthreads();
                if (F.tid < 32) LCNT[blk * 32 + F.tid] = hist[F.tid];
                __syncthreads();
            }
        }
        SEAM(P + 6);
        if (EN(8) && IN(P + 7)) { PHASE_PTRS;
            LAS int* mybase = (LAS int*)(F.lds + TL_BASE); LAS int* rowof = (LAS int*)(F.lds + TL_ROWOF);
            for (int blk = F.vcu; blk < NTOK / 128; blk += F.G) {
                if (F.tid < 64) {
                    const int e = F.lane & 31; int tot = 0, before = 0;
                    for (int j = 0; j < NTOK / 128; ++j) { const int c = LCNT[j * 32 + e]; before += (j < blk) ? c : 0; tot += c; }
                    const int pad = (tot + 255) & ~255; int inc = pad;
#pragma unroll
                    for (int o = 1; o < 32; o <<= 1) { const int nb = __shfl_up(inc, o); if ((F.lane & 31) >= o) inc += nb; }
                    const int off = inc - pad;
                    if (F.lane < 32) { mybase[e] = off + before;
                        if (blk == 0) { OFFS[e] = off; if (e == 31) OFFS[32] = off + pad;
                            for (int t = off >> 8; t < (off + pad) >> 8; ++t) TILE_E[t] = e;
                            for (int r = off + tot; r < off + pad; ++r) { SROW[r] = -1; ROWW[r] = 0.f; } } }
                }
                __syncthreads();
                { const int slot = blk * 512 + F.tid; const int e = SLOT_E[slot]; const int row = mybase[e] + SLOT_LP[slot]; SROW[row] = slot; ROWW[row] = TOPW[slot]; rowof[F.tid] = row; }
                __syncthreads();
                for (int s = F.wave * 64; s < F.wave * 64 + 64; ++s) { const int token = blk * 128 + (s >> 2); const int row = rowof[s];
                    const v4u* src = (const v4u*)(H + (size_t)token * DM); v4u* dst = (v4u*)(XG + (size_t)row * DM);
                    const v4u a = src[F.lane], bq = src[64 + F.lane]; dst[F.lane] = a; dst[64 + F.lane] = bq; }
                __syncthreads();
            }
        }
        SEAM(P + 7);
        if (EN(9) && IN(P + 8)) { PHASE_PTRS;
            const int ntiles = __builtin_amdgcn_readfirstlane(OFFS[32]) >> 8;
            pg8::Gemm g{(const pg8::bf16_t*)XG, (const pg8::bf16_t*)(ws + WS_WUP + l * SZ_WUP), MAXROWS, 2048, DM, (size_t)2048 * DM * 2};
            pg8::GroupOrder S{8, ntiles, F.G, F.bx, TILE_E};
            pg8::EpiUp E{(pg8::bf16_t*)ACT, (const float*)(ws + WS_BUP) + (size_t)l * NE * 2048};
            pg8::gemm_phase<pg8::EpiUp, pg8::GroupOrder, true, true>(F.lds + RING_OFF, g, S, E);
        }
        SEAM(P + 8);
        if (EN(10) && IN(P + 9)) { PHASE_PTRS;
            const int ntiles = __builtin_amdgcn_readfirstlane(OFFS[32]) >> 8;
            pg8::Gemm g{(const pg8::bf16_t*)ACT, (const pg8::bf16_t*)(ws + WS_WDN + l * SZ_WDN), MAXROWS, DM, DM, (size_t)DM * DM * 2};
            pg8::GroupOrder S{4, ntiles, F.G, F.bx, TILE_E};
            pg8::EpiDown E{(pg8::bf16_t*)YB, IP(21  ) + (size_t)l * NE * DM, SROW, ROWW};
            pg8::gemm_phase<pg8::EpiDown, pg8::GroupOrder, true, true>(F.lds + RING_OFF, g, S, E);
        }
        SEAM(P + 9);
    }
    if (EN(11) && IN(N_PHASES - 1)) { const int l = DBG_LAYERS - 1; PHASE_PTRS; float* const outp = (float*)(GAS float*)ptr_ld(F, PT_OUT);
        const float* g2 = MOD + (size_t)(DBG_LAYERS - 1) * NB * 6144 + 5 * 1024;
        for (int row = F.vcu * NWAVES + F.wave; row < NTOK; row += F.G * NWAVES) { const int b = row >> 11;
            f32x4 v[4]; float ss = 0.f;
#pragma unroll
            for (int j = 0; j < 4; ++j) { const int c = 4 * (64 * j + F.lane); v[j] = *(const f32x4*)(XR + (size_t)row * DM + c); f32x4 a = {0.f, 0.f, 0.f, 0.f};
#pragma unroll
                for (int k = 0; k < 4; ++k) { const uint2 y = *(const uint2*)(YB + ((size_t)row * 4 + k) * DM + c); a[0] += bf_lo(y.x); a[1] += bf_hi(y.x); a[2] += bf_lo(y.y); a[3] += bf_hi(y.y); }
                if (DBG_OUT != 1) v[j] += *(const f32x4*)(g2 + (size_t)b * 6144 + c) * a; ss += (v[j][0] * v[j][0] + v[j][1] * v[j][1]) + (v[j][2] * v[j][2] + v[j][3] * v[j][3]); }
            const float rstd = 1.0f / sqrtf(wave_sum(ss) * (1.0f / DM) + NORM_EPS);
            if (DBG_OUT >= 2) {
#pragma unroll
                for (int j = 0; j < 4; ++j) { const int c = 4 * (64 * j + F.lane); f32x4 o = {0.f, 0.f, 0.f, 0.f};
                    auto addb = [&](const bf16* p) { const uint2 y = *(const uint2*)p; o[0] += bf_lo(y.x); o[1] += bf_hi(y.x); o[2] += bf_lo(y.y); o[3] += bf_hi(y.y); };
                    if (DBG_OUT == 2) { if (DBG_SEL & 1) addb(H + (size_t)row * DM + c); if (DBG_SEL & 2) for (int q = 0; q < 3; ++q) addb(GATES + (size_t)row * 3072 + q * 1024 + c); if (DBG_SEL & 4) for (int t = 0; t < 10; ++t) addb(PROJ + (size_t)t * NTOK * 512 + (size_t)row * 512 + (c & 511)); }
                    if (DBG_OUT == 3) { for (int t = 0; t < 3; ++t) addb(OBR + (size_t)t * NTOK * 512 + (size_t)row * 512 + (c & 511)); for (int t = 0; t < 2; ++t) addb((const bf16*)(ws + WS_A12) + (size_t)t * NTOK * 512 + (size_t)row * 512 + (c & 511)); }
                    if (DBG_OUT == 5) { addb((const bf16*)(ws + WS_WIN) + (size_t)(row & 8191) * DM + c); }
                    if (DBG_OUT == 4) { addb((const bf16*)(ws + WS_MERGED) + (size_t)row * DM + c); }
                    *(f32x4*)(outp + (size_t)row * DM + c) = o; }
                continue; }
#pragma unroll
            for (int j = 0; j < 4; ++j) { const int c = 4 * (64 * j + F.lane); *(f32x4*)(outp + (size_t)row * DM + c) = (v[j] * rstd) * *(const f32x4*)(IP(22  ) + c); }
        }
    }
#undef IN
#undef SEAM
#undef GRID_BAR
}

extern "C" void kernel_launch(void* const* d_in, const int* in_sizes, int n_in, void* d_out, int out_size, void* d_ws, size_t ws_size, hipStream_t stream) {
    static int grid = 0;
    if (grid == 0) {
        if (n_in != 23 || in_sizes[0] != NTOK * DM || out_size != NTOK * DM || ws_size < WS_END) { fprintf(stderr, "kernel_launch: unexpected shapes (n_in %d, in0 %d, out %d, ws %zu < %zu); nothing launched\n", n_in, n_in > 0 ? in_sizes[0] : -1, out_size, ws_size, (size_t)WS_END); grid = -1; return; }
        int dev = 0, cus = 0, per_cu = 0;
        if (hipGetDevice(&dev) != hipSuccess || hipDeviceGetAttribute(&cus, hipDeviceAttributeMultiprocessorCount, dev) != hipSuccess) { grid = -1; return; }
        if (hipFuncSetAttribute((const void*)mega_fwd, hipFuncAttributeMaxDynamicSharedMemorySize, LDS_BYTES) != hipSuccess) { fprintf(stderr, "kernel_launch: hipFuncSetAttribute failed\n"); grid = -1; return; }
        if (hipOccupancyMaxActiveBlocksPerMultiprocessor(&per_cu, (const void*)mega_fwd, NWAVES * 64, LDS_BYTES) != hipSuccess || per_cu < 1) fprintf(stderr, "kernel_launch: note: occupancy query reports %d workgroups per CU\n", per_cu);
        (void)hipGetLastError();
        grid = cus;
    }
    if (grid < 0) return;
    if (hipMemsetAsync((char*)d_ws + WS_CTL, 0, CTL_ZERO_BYTES, stream) != hipSuccess) return;
    Args a{};
    const float** ip = (const float**)&a.in;
    for (int i = 0; i < 23; ++i) ip[i] = (const float*)d_in[i];
    a.out = (float*)d_out; a.ws = (unsigned char*)d_ws;
    for (int li = 0; li < N_LAUNCHES; ++li) {
        a.ph_lo = (N_LAUNCHES == 1) ? 0 : li; a.ph_hi = (N_LAUNCHES == 1) ? N_PHASES : li + 1;
        hipLaunchKernelGGL(mega_fwd, dim3(grid), dim3(NWAVES * 64), LDS_BYTES, stream, a);
        const hipError_t le = hipPeekAtLastError();
        if (le != hipSuccess) { fprintf(stderr, "kernel_launch: launch %d failed: %s\n", li, hipGetErrorName(le)); break; }
    }
}
```

```cpp
#include <hip/hip_runtime.h>
#include <hip/hip_bf16.h>
#include <cstdio>
#include <cstdint>
#include <cmath>
namespace pg8 {
#define PG8_LAS __attribute__((address_space(3)))
typedef unsigned short bf16_t;
typedef short bf16x8 __attribute__((ext_vector_type(8)));
typedef float f32x4 __attribute__((ext_vector_type(4)));
typedef unsigned u32x4 __attribute__((ext_vector_type(4)));
constexpr int BM = 256, BK = 64, HALF = 128, HTB = HALF * BK * 2  , STAGE_BYTES = 8 * HTB, NXCD = 8, WGM = 8;

__host__ __device__ __forceinline__ int lds_byte(int r, int c) { const int st = (r >> 4) * 2 + (c >> 5), rr = r & 15, cc = c & 31, ob = rr * 64 + cc * 2; return st * 1024 + (ob ^ (((ob >> 9) & 1) << 5)); }
__host__ __device__ __forceinline__ void stage_rc(int b, int& R, int& C) { const int st = b / 1024, sb = b % 1024, swz = sb ^ (((sb >> 9) & 1) << 5); R = (st >> 1) * 16 + swz / 64; C = (st & 1) * 32 + (swz % 64) / 2; }
__host__ __device__ __forceinline__ int perm32(int rho) { const int n = rho >> 4, i = rho & 15; return 8 * (i >> 2) + 4 * n + (i & 3); }

struct Unit { int pm, pn, e; };
struct Gemm { const bf16_t* A; const bf16_t* Bt; int M, N, K; size_t estride; };

struct StaticOrder {
    int nM, nN, nwg, G, c;
    __host__ __device__ void init(int M, int N, int G_, int c_) { nM = M / BM; nN = N / BM; nwg = nM * nN; G = G_; c = c_; }
    __host__ __device__ bool next(int i, Unit& u) const {
        const long L = (long)i * G + c; if (L >= nwg) return false;
        int wgid = (int)L; { const int q = nwg / NXCD, r = nwg % NXCD, xcd = wgid % NXCD, off = wgid / NXCD; wgid = (xcd < r ? xcd * (q + 1) : r * (q + 1) + (xcd - r) * q) + off; }
        const int nig = WGM * nN, gid = wgid / nig, fm = gid * WGM, gsz = (nM - fm) < WGM ? (nM - fm) : WGM;
        u.pm = fm + ((wgid % nig) % gsz); u.pn = (wgid % nig) / gsz; u.e = 0; return true;
    }
    __device__ __forceinline__ void a_ready(const Unit&) const {}
    __device__ __forceinline__ void done(const Unit&) const {}
};
struct GroupOrder {
    int nN, ntiles, G, c; const int* tile_e;
    __device__ __forceinline__ bool next(int i, Unit& u) const {
        int pm, pn;
        if (G % (NXCD * nN) == 0) { const int rpr = G / nN, rpx = rpr / NXCD, x = c % NXCD, j = c / NXCD; pm = i * rpr + x * rpx + (j % rpx); pn = j / rpx; }
        else { const long L = (long)i * G + c; pm = (int)(L / nN); pn = (int)(L % nN); }
        if (pm >= ntiles) return false;
        u.pm = pm; u.pn = pn; u.e = __builtin_amdgcn_readfirstlane(tile_e[pm]); return true;
    }
    __device__ __forceinline__ void a_ready(const Unit&) const {}
    __device__ __forceinline__ void done(const Unit&) const {}
};
__device__ __forceinline__ unsigned cvt_pk_bf16(float lo, float hi) { typedef float f2_t __attribute__((ext_vector_type(2))); typedef __bf16 b2_t __attribute__((ext_vector_type(2))); const f2_t v = {lo, hi}; const b2_t b = __builtin_convertvector(v, b2_t); return __builtin_bit_cast(unsigned, b); }

template <class Epi, class Sched, bool ALIGN_EPI = false, bool SP2 = false>
__device__ __forceinline__ void gemm_phase(PG8_LAS unsigned char* lds, const Gemm g, const Sched& S, const Epi& E) {
    int tid_ = threadIdx.x; asm volatile("" : "+v"(tid_));
    const int tid = tid_, wid = __builtin_amdgcn_readfirstlane(tid >> 6), lane = tid & 63, wr = wid >> 2, wc = wid & 3, fr = lane & 15, fq = lane >> 4;
    const int K = g.K, nt = K / BK;
    unsigned voffA[2], voffB[2];
#pragma unroll
    for (int i = 0; i < 2; ++i) { int R, C; stage_rc(tid * 16 + i * 8192, R, C); const int Rb = Epi::PERM ? ((R & ~31) + perm32(R & 31)) : R;
        voffA[i] = (unsigned)(R * K + C) * 2u; voffB[i] = (unsigned)(Rb * K + C) * 2u; }
    const size_t kstep = (size_t)(BK * 2);
    const size_t hstep = (size_t)HALF * K * 2;
    const size_t tstep = 2 * hstep;
    const unsigned ldsw = (unsigned)wid * 1024u;
    const int aoff = lds_byte(wr * 64 + fr, fq * 8), boff = lds_byte(wc * 32 + fr, fq * 8);
#define PG8_SA(b, h) (((b) * 2 + (h)) * HTB)
#define PG8_SB(b, h) ((4 + (b) * 2 + (h)) * HTB)
#define PG8_STAGE(bufoff, gbase, voff) do { _Pragma("unroll") for (int _i = 0; _i < 2; ++_i) \
        __builtin_amdgcn_global_load_lds((const unsigned*)((const char*)(gbase) + (voff)[_i]), (PG8_LAS unsigned*)(lds + (bufoff) + ldsw + _i * 8192), 16, 0, 0); } while (0)
#define PG8_LDA(dst, b, h) do { _Pragma("unroll") for (int m = 0; m < 4; ++m) _Pragma("unroll") for (int k = 0; k < 2; ++k) dst[m][k] = *(const PG8_LAS bf16x8*)(lds + PG8_SA(b, h) + aoff + m * 2048 + k * 1024); } while (0)
#define PG8_LDB(dst, b, h) do { _Pragma("unroll") for (int n = 0; n < 2; ++n) _Pragma("unroll") for (int k = 0; k < 2; ++k) dst[n][k] = *(const PG8_LAS bf16x8*)(lds + PG8_SB(b, h) + boff + n * 2048 + k * 1024); } while (0)
#define PG8_MMA(ai, bj, At, Bt) do { __builtin_amdgcn_s_setprio(1); _Pragma("unroll") for (int m = 0; m < 4; ++m) _Pragma("unroll") for (int n = 0; n < 2; ++n) _Pragma("unroll") for (int k = 0; k < 2; ++k) \
        acc[ai][bj][m][n] = __builtin_amdgcn_mfma_f32_16x16x32_bf16(Bt[n][k], At[m][k], acc[ai][bj][m][n], 0, 0, 0); __builtin_amdgcn_s_setprio(0); } while (0)
#define PG8_WAIT_V(n) asm volatile("s_waitcnt vmcnt(" #n ")" ::: "memory")
#define PG8_WAIT_L(n) asm volatile("s_waitcnt lgkmcnt(" #n ")" ::: "memory")
#define PG8_BAR __builtin_amdgcn_s_barrier()
#define PG8_SCHED __builtin_amdgcn_sched_barrier(0)
    Unit cur, nxt; int ui = 0;
    if (!S.next(0, cur)) return;
    f32x4 acc[2][2][4][2];
#pragma unroll
    for (int a = 0; a < 2; ++a)
#pragma unroll
        for (int b = 0; b < 2; ++b)
#pragma unroll
            for (int m = 0; m < 4; ++m)
#pragma unroll
                for (int n = 0; n < 2; ++n) acc[a][b][m][n] = (f32x4){0.f, 0.f, 0.f, 0.f};
    bf16x8 At[4][2], B0[2][2], B1[2][2];
    const char* cA = (const char*)g.A + (size_t)cur.pm * tstep; const char* cB = (const char*)g.Bt + (size_t)cur.e * g.estride + (size_t)cur.pn * tstep;
    S.a_ready(cur);
    if constexpr (SP2) {
        PG8_STAGE(PG8_SB(0, 0), cB, voffB); PG8_STAGE(PG8_SB(0, 1), cB + hstep, voffB); PG8_STAGE(PG8_SA(0, 0), cA, voffA); PG8_STAGE(PG8_SA(0, 1), cA + hstep, voffA);
        if (wr == 1) PG8_BAR;
        PG8_WAIT_V(2); PG8_BAR;
        PG8_STAGE(PG8_SB(1, 0), cB + kstep, voffB); PG8_STAGE(PG8_SA(1, 0), cA + kstep, voffA); PG8_STAGE(PG8_SB(1, 1), cB + hstep + kstep, voffB);
        PG8_WAIT_V(6); PG8_BAR;
    } else {
        PG8_STAGE(PG8_SB(0, 0), cB, voffB); PG8_STAGE(PG8_SA(0, 0), cA, voffA); PG8_STAGE(PG8_SB(0, 1), cB + hstep, voffB); PG8_STAGE(PG8_SA(0, 1), cA + hstep, voffA);
        if (wr == 1) PG8_BAR;
        PG8_WAIT_V(4); PG8_BAR;
        PG8_STAGE(PG8_SB(1, 0), cB + kstep, voffB); PG8_STAGE(PG8_SA(1, 0), cA + kstep, voffA); PG8_STAGE(PG8_SB(1, 1), cB + hstep + kstep, voffB);
        PG8_WAIT_V(6); PG8_BAR;
    }
    for (;;) {
        const bool has_next = S.next(ui + 1, nxt);
        const char* nA = has_next ? (const char*)g.A + (size_t)nxt.pm * tstep : cA; const char* nB = has_next ? (const char*)g.Bt + (size_t)nxt.e * g.estride + (size_t)nxt.pn * tstep : cB;
        for (int t = 0; t < nt; t += 2) {
            const bool last = (t == nt - 2);
            const char* a1 = cA + (size_t)(t + 1) * kstep;
            const char* a2 = last ? nA : cA + (size_t)(t + 2) * kstep; const char* b2 = last ? nB : cB + (size_t)(t + 2) * kstep;
            const char* a3 = a2 + kstep; const char* b3 = b2 + kstep;
            if (last && has_next) S.a_ready(nxt);
            if constexpr (SP2) {
            PG8_LDB(B0, 0, 0); PG8_LDB(B1, 0, 1); PG8_SCHED; PG8_LDA(At, 0, 0); PG8_STAGE(PG8_SA(1, 1), a1 + hstep, voffA);
            PG8_WAIT_V(8); PG8_WAIT_L(0); PG8_BAR; PG8_MMA(0, 0, At, B0); PG8_MMA(0, 1, At, B1); PG8_BAR; PG8_SCHED;
            PG8_LDA(At, 0, 1); PG8_STAGE(PG8_SB(0, 0), b2, voffB); PG8_STAGE(PG8_SB(0, 1), b2 + hstep, voffB); PG8_STAGE(PG8_SA(0, 0), a2, voffA);
            PG8_WAIT_V(8); PG8_WAIT_L(0); PG8_BAR; PG8_MMA(1, 0, At, B0); PG8_MMA(1, 1, At, B1); PG8_BAR; PG8_SCHED;
            PG8_LDB(B0, 1, 0); PG8_LDB(B1, 1, 1); PG8_SCHED; PG8_LDA(At, 1, 0); PG8_STAGE(PG8_SA(0, 1), a2 + hstep, voffA);
            PG8_WAIT_V(8); PG8_WAIT_L(0); PG8_BAR; PG8_MMA(0, 0, At, B0); PG8_MMA(0, 1, At, B1); PG8_BAR; PG8_SCHED;
            PG8_LDA(At, 1, 1); PG8_STAGE(PG8_SB(1, 0), b3, voffB); PG8_STAGE(PG8_SB(1, 1), b3 + hstep, voffB); PG8_STAGE(PG8_SA(1, 0), a3, voffA);
            PG8_WAIT_V(8); PG8_WAIT_L(0); PG8_BAR; PG8_MMA(1, 0, At, B0); PG8_MMA(1, 1, At, B1); PG8_BAR; PG8_SCHED;
            } else {
            PG8_LDB(B0, 0, 0); PG8_SCHED; PG8_LDA(At, 0, 0); PG8_STAGE(PG8_SA(1, 1), a1 + hstep, voffA);
            PG8_WAIT_L(8); PG8_BAR; PG8_WAIT_L(0); PG8_MMA(0, 0, At, B0); PG8_BAR; PG8_SCHED;
            PG8_LDB(B1, 0, 1); PG8_STAGE(PG8_SB(0, 0), b2, voffB);
            PG8_BAR; PG8_WAIT_L(0); PG8_MMA(0, 1, At, B1); PG8_BAR;
            PG8_LDA(At, 0, 1); PG8_STAGE(PG8_SA(0, 0), a2, voffA);
            PG8_BAR; PG8_WAIT_L(0); PG8_MMA(1, 0, At, B0); PG8_BAR; PG8_SCHED;
            PG8_STAGE(PG8_SB(0, 1), b2 + hstep, voffB);
            PG8_WAIT_V(6); PG8_BAR; PG8_MMA(1, 1, At, B1); PG8_BAR;
            PG8_LDB(B0, 1, 0); PG8_SCHED; PG8_LDA(At, 1, 0); PG8_STAGE(PG8_SA(0, 1), a2 + hstep, voffA);
            PG8_WAIT_L(8); PG8_BAR; PG8_WAIT_L(0); PG8_MMA(0, 0, At, B0); PG8_BAR; PG8_SCHED;
            PG8_LDB(B1, 1, 1); PG8_STAGE(PG8_SB(1, 0), b3, voffB);
            PG8_BAR; PG8_WAIT_L(0); PG8_MMA(0, 1, At, B1); PG8_BAR;
            PG8_LDA(At, 1, 1); PG8_STAGE(PG8_SA(1, 0), a3, voffA);
            PG8_BAR; PG8_WAIT_L(0); PG8_MMA(1, 0, At, B0); PG8_BAR; PG8_SCHED;
            PG8_STAGE(PG8_SB(1, 1), b3 + hstep, voffB);
            PG8_WAIT_V(6); PG8_BAR; PG8_MMA(1, 1, At, B1); PG8_BAR;
            }
            if constexpr (Epi::MIDHOOK) { if (((t + 2) & 7) == 0 && t + 2 < nt) E.mid(acc, cur, (t + 2) >> 3, wr, wc, fr, fq); }
        }
        if constexpr (ALIGN_EPI) { if (wr == 0) PG8_BAR; }
        if constexpr (!Epi::AFTER_DRAIN) { E(acc, cur, wr, wc, fr, fq); S.done(cur); }
        if (!has_next) break;
#pragma unroll
        for (int a = 0; a < 2; ++a)
#pragma unroll
            for (int b = 0; b < 2; ++b)
#pragma unroll
                for (int m = 0; m < 4; ++m)
#pragma unroll
                    for (int n = 0; n < 2; ++n) acc[a][b][m][n] = (f32x4){0.f, 0.f, 0.f, 0.f};
        cur = nxt; cA = nA; cB = nB; ++ui;
        if constexpr (ALIGN_EPI) { if (wr == 1) PG8_BAR; }
    }
    PG8_WAIT_V(0);
    if constexpr (!ALIGN_EPI) { if (wr == 0) PG8_BAR; }
    PG8_BAR;
    if constexpr (Epi::AFTER_DRAIN) { E.fused(acc, cur, wr, wc, fr, fq, lds, wid, lane); S.done(cur); }
#undef PG8_SA
#undef PG8_SB
#undef PG8_STAGE
#undef PG8_LDA
#undef PG8_LDB
#undef PG8_MMA
#undef PG8_WAIT_V
#undef PG8_WAIT_L
#undef PG8_BAR
#undef PG8_SCHED
}
}
namespace pg8 {
typedef unsigned u32x2 __attribute__((ext_vector_type(2)));
constexpr int EP_NTOK = 32768;
constexpr float EP_C2 = 0.125f * 1.4426950408889634f;
__device__ __forceinline__ float sigm(float x) { return __builtin_amdgcn_rcpf(1.0f + __builtin_amdgcn_exp2f(-1.4426950408889634f * x)); }
__device__ __forceinline__ f32x4 sigm4(f32x4 v) { f32x4 o; o[0] = sigm(v[0]); o[1] = sigm(v[1]); o[2] = sigm(v[2]); o[3] = sigm(v[3]); return o; }
__device__ __forceinline__ u32x4 pack8(f32x4 v0, f32x4 v1) { u32x4 w; w.x = cvt_pk_bf16(v0[0], v0[1]); w.y = cvt_pk_bf16(v0[2], v0[3]); w.z = cvt_pk_bf16(v1[0], v1[1]); w.w = cvt_pk_bf16(v1[2], v1[3]); return w; }
__device__ __forceinline__ float bflo(unsigned u) { return __builtin_bit_cast(float, u << 16); }
__device__ __forceinline__ float bfhi(unsigned u) { return __builtin_bit_cast(float, u & 0xffff0000u); }

struct EpiInProj {
    static constexpr bool PERM = true, AFTER_DRAIN = false, MIDHOOK = false;
    bf16_t* proj; bf16_t* gates; const float* gate_b; const float* rope;
    __device__ __forceinline__ void operator()(const f32x4 (&acc)[2][2][4][2], const Unit& u, int wr, int wc, int fr, int fq) const {
        const int pn = u.pn; const int row0 = u.pm * BM + wr * 64 + fr;
        if (pn >= 20) {
            const int col0 = (pn - 20) * BM + wc * 32 + 8 * fq;
            f32x4 bv[2][2];
#pragma unroll
            for (int bj = 0; bj < 2; ++bj)
#pragma unroll
                for (int n = 0; n < 2; ++n) bv[bj][n] = *(const f32x4*)(gate_b + col0 + bj * HALF + 4 * n);
#pragma unroll
            for (int ai = 0; ai < 2; ++ai)
#pragma unroll
                for (int m = 0; m < 4; ++m) { bf16_t* rowp = gates + (size_t)(row0 + ai * HALF + m * 16) * 3072 + col0;
#pragma unroll
                    for (int bj = 0; bj < 2; ++bj) { const f32x4 v0 = sigm4(acc[ai][bj][m][0] + bv[bj][0]), v1 = sigm4(acc[ai][bj][m][1] + bv[bj][1]); *(u32x4*)(rowp + bj * HALF) = pack8(v0, v1); } }
        } else {
            const int t = pn >> 1; bf16_t* base = proj + (size_t)t * ((size_t)EP_NTOK * 512); const int colt = (pn & 1) * BM;
            if (t == 3 || t == 4) {
                const float sc = (t == 4) ? 0.08838834764831845f : 1.0f;
                const int hl = wc >> 1, i0 = (wc & 1) * 32 + 8 * fq;
#pragma unroll
                for (int ai = 0; ai < 2; ++ai)
#pragma unroll
                    for (int m = 0; m < 4; ++m) { const int row = row0 + ai * HALF + m * 16; const int pos = row & 2047;
                        const float* rp = rope + ((size_t)pos * 64 + i0) * 2;
                        f32x4 cs[4];
#pragma unroll
                        for (int q = 0; q < 4; ++q) cs[q] = *(const f32x4*)(rp + 4 * q);
                        f32x4 o1[2], o2[2];
#pragma unroll
                        for (int n = 0; n < 2; ++n)
#pragma unroll
                            for (int i = 0; i < 4; ++i) { const int idx = 4 * n + i; const float c = cs[idx >> 1][(idx & 1) * 2], s = cs[idx >> 1][(idx & 1) * 2 + 1];
                                const float x1 = acc[ai][0][m][n][i], x2 = acc[ai][1][m][n][i]; o1[n][i] = (x1 * c - x2 * s) * sc; o2[n][i] = (x1 * s + x2 * c) * sc; }
                        bf16_t* rowp = base + (size_t)row * 512 + colt + hl * 128 + i0;
                        *(u32x4*)(rowp) = pack8(o1[0], o1[1]); *(u32x4*)(rowp + 64) = pack8(o2[0], o2[1]); }
            } else {
                const float sc = (t == 0 || t == 7) ? EP_C2 : 1.0f; const bool silu = (t == 6);
                const int col0 = colt + wc * 32 + 8 * fq;
#pragma unroll
                for (int ai = 0; ai < 2; ++ai)
#pragma unroll
                    for (int m = 0; m < 4; ++m) { bf16_t* rowp = base + (size_t)(row0 + ai * HALF + m * 16) * 512 + col0;
#pragma unroll
                        for (int bj = 0; bj < 2; ++bj) { f32x4 v0 = acc[ai][bj][m][0], v1 = acc[ai][bj][m][1];
                            if (silu) { v0 = v0 * sigm4(v0); v1 = v1 * sigm4(v1); }
                            v0 = v0 * sc; v1 = v1 * sc; *(u32x4*)(rowp + bj * HALF) = pack8(v0, v1); } }
            }
        }
    }
};

struct EpiGate3 {
    static constexpr bool PERM = false, AFTER_DRAIN = false, MIDHOOK = true;
    const bf16_t* G; bf16_t* MB;
    __device__ __forceinline__ void mid(f32x4 (&acc)[2][2][4][2], const Unit& u, int seg, int wr, int wc, int fr, int fq) const {
        const int row0 = u.pm * BM + wr * 64 + fr, col0 = u.pn * BM + wc * 32 + 4 * fq; const bf16_t* Ga = G + (seg - 1) * 1024; const bf16_t* Gb = G + seg * 1024;
#pragma unroll
        for (int ai = 0; ai < 2; ++ai)
#pragma unroll
            for (int m = 0; m < 4; ++m) { const size_t ro = (size_t)(row0 + ai * HALF + m * 16) * 3072 + col0;
#pragma unroll
                for (int bj = 0; bj < 2; ++bj)
#pragma unroll
                    for (int n = 0; n < 2; ++n) { const int c = bj * HALF + n * 16;
                        const u32x2 ga = *(const u32x2*)(Ga + ro + c), gb = *(const u32x2*)(Gb + ro + c);
                        const f32x4 r = {bflo(ga.x) * __builtin_amdgcn_rcpf(bflo(gb.x)), bfhi(ga.x) * __builtin_amdgcn_rcpf(bfhi(gb.x)), bflo(ga.y) * __builtin_amdgcn_rcpf(bflo(gb.y)), bfhi(ga.y) * __builtin_amdgcn_rcpf(bfhi(gb.y))};
                        acc[ai][bj][m][n] = acc[ai][bj][m][n] * r; }
                asm volatile("" ::: "memory"); }
    }
    __device__ __forceinline__ void operator()(const f32x4 (&acc)[2][2][4][2], const Unit& u, int wr, int wc, int fr, int fq) const {
        const int row0 = u.pm * BM + wr * 64 + fr, col0 = u.pn * BM + wc * 32 + 4 * fq; const bf16_t* Gc = G + 2048;
#pragma unroll
        for (int ai = 0; ai < 2; ++ai)
#pragma unroll
            for (int m = 0; m < 4; ++m) { const size_t row = (size_t)(row0 + ai * HALF + m * 16);
#pragma unroll
                for (int bj = 0; bj < 2; ++bj)
#pragma unroll
                    for (int n = 0; n < 2; ++n) { const int c = col0 + bj * HALF + n * 16;
                        const u32x2 gw = *(const u32x2*)(Gc + row * 3072 + c); const f32x4 g = {bflo(gw.x), bfhi(gw.x), bflo(gw.y), bfhi(gw.y)};
                        const f32x4 v = acc[ai][bj][m][n] * g; u32x2 w; w.x = cvt_pk_bf16(v[0], v[1]); w.y = cvt_pk_bf16(v[2], v[3]); *(u32x2*)(MB + row * 1024 + c) = w; }
                if (m & 1) asm volatile("" ::: "memory"); }
    }
};

struct EpiResid {
    static constexpr bool PERM = false, AFTER_DRAIN = false, MIDHOOK = false;
    const float* XI; float* XO; const float* g1;
    __device__ __forceinline__ void operator()(const f32x4 (&acc)[2][2][4][2], const Unit& u, int wr, int wc, int fr, int fq) const {
        const int row0 = u.pm * BM + wr * 64 + fr, col0 = u.pn * BM + wc * 32 + 4 * fq; const float* gp = g1 + (size_t)(u.pm >> 3) * 6144 + col0;
        f32x4 gv[2][2];
#pragma unroll
        for (int bj = 0; bj < 2; ++bj)
#pragma unroll
            for (int n = 0; n < 2; ++n) gv[bj][n] = *(const f32x4*)(gp + bj * HALF + n * 16);
#pragma unroll
        for (int ai = 0; ai < 2; ++ai)
#pragma unroll
            for (int m = 0; m < 4; ++m) { const size_t off = (size_t)(row0 + ai * HALF + m * 16) * 1024 + col0;
#pragma unroll
                for (int bj = 0; bj < 2; ++bj)
#pragma unroll
                    for (int n = 0; n < 2; ++n) { const f32x4 xi = *(const f32x4*)(XI + off + bj * HALF + n * 16); *(f32x4*)(XO + off + bj * HALF + n * 16) = xi + gv[bj][n] * acc[ai][bj][m][n]; }
                if (m & 1) asm volatile("" ::: "memory"); }
    }
};

struct EpiUp {
    static constexpr bool PERM = true, AFTER_DRAIN = false, MIDHOOK = false;
    bf16_t* ACT; const float* bup;
    __device__ __forceinline__ void operator()(const f32x4 (&acc)[2][2][4][2], const Unit& u, int wr, int wc, int fr, int fq) const {
        const int row0 = u.pm * BM + wr * 64 + fr; const float* bp = bup + (size_t)u.e * 2048 + u.pn * BM + wc * 32 + 8 * fq;
        const int col0 = u.pn * HALF + wc * 32 + 8 * fq;
        f32x4 bv[2][2];
#pragma unroll
        for (int bj = 0; bj < 2; ++bj)
#pragma unroll
            for (int n = 0; n < 2; ++n) bv[bj][n] = *(const f32x4*)(bp + bj * HALF + 4 * n);
#pragma unroll
        for (int ai = 0; ai < 2; ++ai)
#pragma unroll
            for (int m = 0; m < 4; ++m) { f32x4 o[2];
#pragma unroll
                for (int n = 0; n < 2; ++n) { const f32x4 gl = acc[ai][0][m][n] + bv[0][n], li = acc[ai][1][m][n] + bv[1][n];
#pragma unroll
                    for (int i = 0; i < 4; ++i) { const float a = __builtin_fminf(gl[i], 7.0f), l = __builtin_fminf(__builtin_fmaxf(li[i], -7.0f), 7.0f); o[n][i] = a * sigm(1.702f * a) * (l + 1.0f); } }
                *(u32x4*)(ACT + (size_t)(row0 + ai * HALF + m * 16) * 1024 + col0) = pack8(o[0], o[1]); }
    }
};

struct EpiDown {
    static constexpr bool PERM = true, AFTER_DRAIN = false, MIDHOOK = false;
    bf16_t* Y; const float* bdn; const int* srow; const float* roww;
    __device__ __forceinline__ void operator()(const f32x4 (&acc)[2][2][4][2], const Unit& u, int wr, int wc, int fr, int fq) const {
        const int row0 = u.pm * BM + wr * 64 + fr; const int col0 = u.pn * BM + wc * 32 + 8 * fq; const float* bp = bdn + (size_t)u.e * 1024 + col0;
        f32x4 bv[2][2];
#pragma unroll
        for (int bj = 0; bj < 2; ++bj)
#pragma unroll
            for (int n = 0; n < 2; ++n) bv[bj][n] = *(const f32x4*)(bp + bj * HALF + 4 * n);
#pragma unroll
        for (int ai = 0; ai < 2; ++ai)
#pragma unroll
            for (int m = 0; m < 4; ++m) { const int row = row0 + ai * HALF + m * 16; const int slot = srow[row]; const float w = roww[row];
                if (slot >= 0) { bf16_t* rowp = Y + (size_t)slot * 1024 + col0;
#pragma unroll
                    for (int bj = 0; bj < 2; ++bj) { const f32x4 v0 = (acc[ai][bj][m][0] + bv[bj][0]) * w, v1 = (acc[ai][bj][m][1] + bv[bj][1]) * w; *(u32x4*)(rowp + bj * HALF) = pack8(v0, v1); } } }
    }
};
}
namespace attn_body {

using bf16=__hip_bfloat16;
using bf16x8=__attribute__((ext_vector_type(8)))short;
using s16x4=__attribute__((ext_vector_type(4)))short;
using f32x16=__attribute__((ext_vector_type(16)))float;
using u32x4=__attribute__((ext_vector_type(4)))unsigned;
using f32x4_t=__attribute__((ext_vector_type(4)))float;
constexpr int D=64,PITCH=512;
constexpr int NW=8,QBLK=32,QB=QBLK*NW,KVBLK=64;
constexpr int ATTN_PITCH=PITCH, ATTN_UNIT_ROWS=QB;
__device__ __forceinline__ int crow(int r,int hi){return (r&3)+8*(r>>2)+4*hi;}
#define SBAR() __builtin_amdgcn_sched_barrier(0)
__device__ __forceinline__ void cmask(f32x16&p0,f32x16&p1,int jb,int qrel,int hi){
  const float NEG=-INFINITY; int kb=64*jb+4*hi;
  #pragma unroll
  for(int r=0;r<16;++r){int kv=kb+(r&3)+8*(r>>2); if(kv>qrel)p0[r]=NEG; if(kv+32>qrel)p1[r]=NEG;}
}

constexpr int NSLOT=3, SLOTB=8192;
constexpr int LDS_K=0, LDS_V=NSLOT*SLOTB, LDS_WS=2*NSLOT*SLOTB, LDS_OST=LDS_WS+NW*64*4, LDS_FB=LDS_OST+NW*4096, LDS_BYTES=LDS_FB+8192;
constexpr float C2=0.125f*1.4426950408889634f;
__device__ __forceinline__ void glds16(const void*gsrc,unsigned lds_dst){unsigned keep;
  asm volatile("s_mov_b32 %0, m0\n\ts_mov_b32 m0, %2\n\ts_nop 0\n\tglobal_load_lds_dwordx4 %1, off\n\ts_mov_b32 m0, %0":"=&s"(keep):"v"(gsrc),"s"(lds_dst):"memory");}
__device__ __forceinline__ float max3f(float a,float b,float c){float r;asm("v_max3_f32 %0, %1, %2, %3":"=v"(r):"v"(a),"v"(b),"v"(c));return r;}
__device__ __forceinline__ float max2f(float a,float b){float r;asm("v_max_f32_e32 %0, %1, %2":"=v"(r):"v"(a),"v"(b));return r;}
__device__ __forceinline__ float fadd_s(float a,float b){float r;asm("v_add_f32_e32 %0, %1, %2":"=v"(r):"v"(a),"v"(b));return r;}
__device__ __forceinline__ float fsub_s(float a,float b){float r;asm("v_sub_f32_e32 %0, %1, %2":"=v"(r):"v"(a),"v"(b));return r;}
typedef float f32x2_t __attribute__((ext_vector_type(2))); typedef __bf16 bf16x2_t __attribute__((ext_vector_type(2)));
__device__ __forceinline__ unsigned cvtpk_s(float lo,float hi){f32x2_t v={lo,hi};bf16x2_t b=__builtin_convertvector(v,bf16x2_t);return __builtin_bit_cast(unsigned,b);}
#define WAIT_BAR(N) asm volatile("s_waitcnt vmcnt(" #N ") lgkmcnt(0)\n\ts_barrier":::"memory")

__device__ __forceinline__ void qkt(f32x16&p0,f32x16&p1,const char*Kslot,const bf16x8*qr,const f32x16&negm,int r32,int hi){
  const char*kb=Kslot+hi*1024+r32*16;
  #pragma unroll
  for(int d0=0;d0<4;++d0){
    const bf16x8 b0=*reinterpret_cast<const bf16x8*>(kb+d0*2048);
    const bf16x8 b1=*reinterpret_cast<const bf16x8*>(kb+d0*2048+512);
    if(d0==0){p0=__builtin_amdgcn_mfma_f32_32x32x16_bf16(b0,qr[0],negm,0,0,0);p1=__builtin_amdgcn_mfma_f32_32x32x16_bf16(b1,qr[0],negm,0,0,0);}
    else{p0=__builtin_amdgcn_mfma_f32_32x32x16_bf16(b0,qr[d0],p0,0,0,0);p1=__builtin_amdgcn_mfma_f32_32x32x16_bf16(b1,qr[d0],p1,0,0,0);}}
}
__device__ __forceinline__ void qkt_acc(f32x16&p0,f32x16&p1,const char*Kslot,const bf16x8*qr,int r32,int hi){
  const char*kb=Kslot+hi*1024+r32*16;
  #pragma unroll
  for(int d0=0;d0<4;++d0){
    const bf16x8 b0=*reinterpret_cast<const bf16x8*>(kb+d0*2048);
    const bf16x8 b1=*reinterpret_cast<const bf16x8*>(kb+d0*2048+512);
    p0=__builtin_amdgcn_mfma_f32_32x32x16_bf16(b0,qr[d0],p0,0,0,0);p1=__builtin_amdgcn_mfma_f32_32x32x16_bf16(b1,qr[d0],p1,0,0,0);}
}
typedef __attribute__((address_space(3))) const char* lds_cptr;
typedef short v4i16_t __attribute__((ext_vector_type(4)));
__device__ __forceinline__ void kload8(bf16x8*kf,lds_cptr kp){
  kf[0]=*(const __attribute__((address_space(3))) bf16x8*)(kp);      kf[1]=*(const __attribute__((address_space(3))) bf16x8*)(kp+512);
  kf[2]=*(const __attribute__((address_space(3))) bf16x8*)(kp+2048); kf[3]=*(const __attribute__((address_space(3))) bf16x8*)(kp+2560);
  kf[4]=*(const __attribute__((address_space(3))) bf16x8*)(kp+4096); kf[5]=*(const __attribute__((address_space(3))) bf16x8*)(kp+4608);
  kf[6]=*(const __attribute__((address_space(3))) bf16x8*)(kp+6144); kf[7]=*(const __attribute__((address_space(3))) bf16x8*)(kp+6656);
}
__device__ __forceinline__ void kload2(bf16x8*kf,lds_cptr kp,int j){ kf[2*j]=*(const __attribute__((address_space(3))) bf16x8*)(kp+j*2048); kf[2*j+1]=*(const __attribute__((address_space(3))) bf16x8*)(kp+j*2048+512); }
__device__ __forceinline__ s16x4 vtr(lds_cptr p){ return __builtin_bit_cast(s16x4,__builtin_amdgcn_ds_read_tr16_b64_v4i16((__attribute__((address_space(3))) v4i16_t*)p)); }
__device__ __forceinline__ float rowmax(const f32x16&p0,const f32x16&p1){
  float a=max3f(p0[0],p0[1],p1[0]),b=max3f(p0[2],p0[3],p1[1]);a=max3f(a,p1[2],p1[3]);
  #pragma unroll
  for(int r=4;r<16;r+=4){a=max3f(a,p0[r],p0[r+1]);b=max3f(b,p0[r+2],p0[r+3]);a=max3f(a,p1[r],p1[r+1]);b=max3f(b,p1[r+2],p1[r+3]);}
  const float m=max2f(a,b);
  auto rr=__builtin_amdgcn_permlane32_swap(__float_as_uint(m),__float_as_uint(m),false,false);
  return max2f(__uint_as_float(rr[0]),__uint_as_float(rr[1]));
}
__device__ __forceinline__ void pv(f32x16*o,int vb,bf16x8 pa0,bf16x8 pa1,bf16x8 pa2,bf16x8 pa3){
  #pragma unroll
  for(int d0=0;d0<2;++d0){s16x4 lo[4],hi[4];
    #pragma unroll
    for(int ks=0;ks<4;++ks){
      asm volatile("ds_read_b64_tr_b16 %0,%1 offset:%c2":"=&v"(lo[ks]):"v"(vb),"i"(d0*4096+ks*1024):"memory");
      asm volatile("ds_read_b64_tr_b16 %0,%1 offset:%c2":"=&v"(hi[ks]):"v"(vb),"i"(d0*4096+ks*1024+512):"memory");}
    asm volatile("s_waitcnt lgkmcnt(0)":::"memory");SBAR();
    #define PK(k) (bf16x8){lo[k][0],lo[k][1],lo[k][2],lo[k][3],hi[k][0],hi[k][1],hi[k][2],hi[k][3]}
    o[d0]=__builtin_amdgcn_mfma_f32_32x32x16_bf16(pa0,PK(0),o[d0],0,0,0);
    o[d0]=__builtin_amdgcn_mfma_f32_32x32x16_bf16(pa1,PK(1),o[d0],0,0,0);
    o[d0]=__builtin_amdgcn_mfma_f32_32x32x16_bf16(pa2,PK(2),o[d0],0,0,0);
    o[d0]=__builtin_amdgcn_mfma_f32_32x32x16_bf16(pa3,PK(3),o[d0],0,0,0);
    #undef PK
  }
}

#ifndef ATTN_STORE16
#define ATTN_STORE16(p,v) (*(u32x4*)(p)=(v))
#endif
template<int THRL,bool FB> __device__ __forceinline__ void attn_unit(int qb,const bf16*Qh,const bf16*__restrict__ Kh,const bf16*__restrict__ Vh,bf16*Oh,int opitch,const float*fbg,char*shm){
  int tid_=threadIdx.x; asm volatile("":"+v"(tid_)); const int tid=tid_,lane=tid&63,r32=lane&31,hi=lane>>5; const int wid=__builtin_amdgcn_readfirstlane(tid>>6);
  const int q0=qb*QB;
  const bf16*Qw=Qh+(long)(q0+wid*QBLK)*PITCH;
  const lds_cptr shm3=(lds_cptr)shm;
  const unsigned lds0=(unsigned)(uintptr_t)shm;
  float*wsf=(float*)(shm+LDS_WS)+wid*64;
  const bf16*ksrc=Kh+(long)lane*PITCH+wid*8;
  const bf16*vsrc=Vh+(long)(16*(wid&3)+(lane>>2))*PITCH+(wid>>2)*32+(lane&3)*8;
  const unsigned kdst=lds0+LDS_K+wid*1024, vdst=lds0+LDS_V+wid*1024;
  #define DMA_K(t,slot) glds16(ksrc+(long)(t)*KVBLK*PITCH,(unsigned)__builtin_amdgcn_readfirstlane(kdst+(slot)))
  #define DMA_V(t,slot) glds16(vsrc+(long)(t)*KVBLK*PITCH,(unsigned)__builtin_amdgcn_readfirstlane(vdst+(slot)))
  const int vb0=(int)(lds0+LDS_V)+((lane>>4)&1)*32+(lane&3)*8+(4*hi+((lane&15)>>2))*64;
  const char*Kbase=shm+LDS_K; bf16x8 kf[8];
  const lds_cptr kp0=shm3+LDS_K+hi*1024+r32*16; const lds_cptr vp0=shm3+LDS_V+((lane>>4)&1)*32+(lane&3)*8+(4*hi+((lane&15)>>2))*64;
  const int NT=(q0+QB)/KVBLK;
  typedef __attribute__((address_space(3))) float* lds_fptr; typedef __attribute__((address_space(3))) const f32x4_t* lds_f4cptr;
  if(FB){ lds_fptr fbw=(lds_fptr)(shm3+LDS_FB); for(int i=tid;i<q0+QB;i+=NW*64) fbw[i]=fbg[i]; }
  const lds_cptr fbp=shm3+LDS_FB+16*hi;
  #define FBINIT(P0,P1,t) do{ if(FB){ _Pragma("unroll") for(int g_=0;g_<4;++g_){ const f32x4_t a_=*(lds_f4cptr)(fbp+(t)*256+g_*32); const f32x4_t b_=*(lds_f4cptr)(fbp+(t)*256+128+g_*32); \
      P0[4*g_]=a_[0]-mhat;P0[4*g_+1]=a_[1]-mhat;P0[4*g_+2]=a_[2]-mhat;P0[4*g_+3]=a_[3]-mhat; P1[4*g_]=b_[0]-mhat;P1[4*g_+1]=b_[1]-mhat;P1[4*g_+2]=b_[2]-mhat;P1[4*g_+3]=b_[3]-mhat; } } }while(0)
  DMA_K(0,0);DMA_V(0,0);DMA_K(1,SLOTB);
  bf16x8 qr[4];
  #pragma unroll
  for(int d0=0;d0<4;++d0)qr[d0]=*reinterpret_cast<const bf16x8*>(&Qw[(long)r32*PITCH+d0*16+hi*8]);
  float mhat=0.f,l_reg=0.f;f32x16 o[2];o[0]=f32x16{};o[1]=f32x16{};f32x16 negm=f32x16{};if(!FB)asm volatile("":"+v"(negm));
  const int qrel=wid*QBLK+r32;
  #define CMASK(P0,P1,t) do{int jb_=(t)-(NT-4); if(jb_>=0)cmask(P0,P1,jb_,qrel,hi);}while(0)
  bool resc=false;
  #define START(P0,P1) do{ const float rm=rowmax(P0,P1); resc=false; \
    { const float dl=rm; mhat=fadd_s(mhat,dl); \
      _Pragma("unroll") for(int r=0;r<16;++r){P0[r]=fsub_s(P0[r],dl);P1[r]=fsub_s(P1[r],dl);} \
      if(!FB){ _Pragma("unroll") for(int r=0;r<16;++r)negm[r]=-mhat; asm volatile("":"+v"(negm)); } } \
    _Pragma("unroll") for(int r=0;r<16;++r)P0[r]=__builtin_amdgcn_exp2f(P0[r]); }while(0)
  #define RESC() do{ if(resc){ asm volatile("s_waitcnt lgkmcnt(0)":::"memory"); \
      _Pragma("unroll") for(int d_=0;d_<2;++d_) _Pragma("unroll") for(int r=0;r<16;++r)o[d_][r]*=wsf[crow(r,hi)]; } }while(0)
  f32x16 pA0,pA1,pB0,pB1;
  int sl_prev=0,sl_cur=0,sl_next=SLOTB;
  #define ROT() do{sl_prev=sl_cur;sl_cur=sl_next;sl_next=(sl_next==(NSLOT-1)*SLOTB)?0:sl_next+SLOTB;}while(0)
  DMA_K(2,2*SLOTB);
  WAIT_BAR(3);
  if(FB){ FBINIT(pA0,pA1,0); qkt_acc(pA0,pA1,Kbase,qr,r32,hi); } else qkt(pA0,pA1,Kbase,qr,negm,r32,hi);
  asm volatile("s_nop 15\n\ts_nop 7":"+v"(pA0),"+v"(pA1));CMASK(pA0,pA1,0);
  START(pA0,pA1);
  _Pragma("unroll") for(int r=0;r<16;++r)pA1[r]=__builtin_amdgcn_exp2f(pA1[r]);
  WAIT_BAR(0);
  DMA_K(3,0);DMA_V(1,SLOTB);
  ROT();
  kload8(kf,kp0+sl_cur);
  WAIT_BAR(2);
  s16x4 vlo[8],vhi[8]; u32x4 pw0,pw1,pw2,pw3;
  #define PKW(P,B) cvtpk_s(P[B],P[B+1])
  #define PAF(k) __builtin_bit_cast(bf16x8,pw##k)
  #define VFR(i) (bf16x8){vlo[i][0],vlo[i][1],vlo[i][2],vlo[i][3],vhi[i][0],vhi[i][1],vhi[i][2],vhi[i][3]}
  #define PIN(x) asm volatile("":"+v"(x))
  #define MX3(a,b,c) __builtin_fmaxf(__builtin_fmaxf((a),(b)),(c))
  #define GAPA(MF,A0,A1,A2,A3,W0,W1,PW) do{ MF; sacc+=A0; sacc+=A1; sacc+=A2; sacc+=A3; PIN(sacc); W0; W1; PIN(PW); SBAR(); }while(0)
  #define EX(v) __builtin_amdgcn_exp2f(v)
  #define GAPB(MF,X,B) do{ MF; X[B]=EX(X[B]); X[B+1]=EX(X[B+1]); X[B+2]=EX(X[B+2]); X[B+3]=EX(X[B+3]); PIN(X); SBAR(); }while(0)
  #define VRD(i) do{ vlo[i]=vtr(vp_+(((i)>>2)*4096+((i)&3)*1024)); vhi[i]=vtr(vp_+(((i)>>2)*4096+((i)&3)*1024+512)); }while(0)
  #define KRD(G,j) do{ if(G){ kload2(kf,kp0+sl_next,j); SBAR(); } }while(0)
  #define STEP(C0,C1,P0,P1,t,GK,GV,GL) do{ FBINIT(C0,C1,t); SBAR(); \
    const lds_cptr vp_=vp0+sl_prev; \
    VRD(0); SBAR(); float sacc=(P0[0]+P0[1]); \
    GAPA(C0=__builtin_amdgcn_mfma_f32_32x32x16_bf16(kf[0],qr[0],(FB?C0:negm),0,0,0), P0[2],P0[3],P0[4],P0[5],     pw0[0]=PKW(P0,0), pw0[1]=PKW(P0,2), pw0); \
    VRD(4); SBAR(); GAPA(C1=__builtin_amdgcn_mfma_f32_32x32x16_bf16(kf[1],qr[0],(FB?C1:negm),0,0,0), P0[6],P0[7],P0[8],P0[9],     pw0[2]=PKW(P0,4), pw0[3]=PKW(P0,6), pw0); \
    VRD(1); SBAR(); GAPA(C0=__builtin_amdgcn_mfma_f32_32x32x16_bf16(kf[2],qr[1],C0,0,0,0),   P0[10],P0[11],P0[12],P0[13], pw1[0]=PKW(P0,8), pw1[1]=PKW(P0,10), pw1); \
    VRD(5); SBAR(); GAPA(C1=__builtin_amdgcn_mfma_f32_32x32x16_bf16(kf[3],qr[1],C1,0,0,0),   P0[14],P0[15],P1[0],P1[1],   pw1[2]=PKW(P0,12),pw1[3]=PKW(P0,14), pw1); \
    VRD(2); SBAR(); GAPA(C0=__builtin_amdgcn_mfma_f32_32x32x16_bf16(kf[4],qr[2],C0,0,0,0),   P1[2],P1[3],P1[4],P1[5],     pw2[0]=PKW(P1,0), pw2[1]=PKW(P1,2), pw2); \
    VRD(6); SBAR(); GAPA(C1=__builtin_amdgcn_mfma_f32_32x32x16_bf16(kf[5],qr[2],C1,0,0,0),   P1[6],P1[7],P1[8],P1[9],     pw2[2]=PKW(P1,4), pw2[3]=PKW(P1,6), pw2); \
    VRD(3); SBAR(); GAPA(C0=__builtin_amdgcn_mfma_f32_32x32x16_bf16(kf[6],qr[3],C0,0,0,0),   P1[10],P1[11],P1[12],P1[13], pw3[0]=PKW(P1,8), pw3[1]=PKW(P1,10), pw3); \
    VRD(7); SBAR(); GAPA(C1=__builtin_amdgcn_mfma_f32_32x32x16_bf16(kf[7],qr[3],C1,0,0,0),   P1[14],P1[15],0.f,0.f,       pw3[2]=PKW(P1,12),pw3[3]=PKW(P1,14), pw3); \
    l_reg+=sacc; \
    if(GK){DMA_K((t)+3,sl_cur);} if(GV){DMA_V((t)+1,sl_next);} \
    CMASK(C0,C1,t); \
    { float a=MX3(C0[0],C0[1],C1[0]),b=MX3(C0[2],C0[3],C1[1]); a=MX3(a,C1[2],C1[3]); \
      _Pragma("unroll") for(int r=4;r<16;r+=4){a=MX3(a,C0[r],C0[r+1]);b=MX3(b,C0[r+2],C0[r+3]);a=MX3(a,C1[r],C1[r+1]);b=MX3(b,C1[r+2],C1[r+3]);} \
      float rm=__builtin_fmaxf(a,b); { auto rr=__builtin_amdgcn_permlane32_swap(__float_as_uint(rm),__float_as_uint(rm),false,false); rm=__builtin_fmaxf(__uint_as_float(rr[0]),__uint_as_float(rr[1])); } \
      resc=false; \
      if(__builtin_expect(__any(rm>(float)THRL),0)){ const float dl=__builtin_fmaxf(rm,0.f); mhat+=dl; \
        _Pragma("unroll") for(int r=0;r<16;++r){C0[r]-=dl;C1[r]-=dl;} \
        if(!FB){ _Pragma("unroll") for(int r=0;r<16;++r)negm[r]=-mhat; asm volatile("":"+v"(negm)); } \
        const float f=__builtin_amdgcn_exp2f(-dl); l_reg*=f; if(hi==0)wsf[r32]=f; resc=true; } } \
    SBAR(); \
    GAPB(o[0]=__builtin_amdgcn_mfma_f32_32x32x16_bf16(PAF(0),VFR(0),o[0],0,0,0), C0,0); \
    GAPB(o[1]=__builtin_amdgcn_mfma_f32_32x32x16_bf16(PAF(0),VFR(4),o[1],0,0,0), C0,4); \
    KRD(GL,0); GAPB(o[0]=__builtin_amdgcn_mfma_f32_32x32x16_bf16(PAF(1),VFR(1),o[0],0,0,0), C0,8); \
    KRD(GL,1); GAPB(o[1]=__builtin_amdgcn_mfma_f32_32x32x16_bf16(PAF(1),VFR(5),o[1],0,0,0), C0,12); \
    KRD(GL,2); GAPB(o[0]=__builtin_amdgcn_mfma_f32_32x32x16_bf16(PAF(2),VFR(2),o[0],0,0,0), C1,0); \
    KRD(GL,3); GAPB(o[1]=__builtin_amdgcn_mfma_f32_32x32x16_bf16(PAF(2),VFR(6),o[1],0,0,0), C1,4); \
    GAPB(o[0]=__builtin_amdgcn_mfma_f32_32x32x16_bf16(PAF(3),VFR(3),o[0],0,0,0), C1,8); \
    GAPB(o[1]=__builtin_amdgcn_mfma_f32_32x32x16_bf16(PAF(3),VFR(7),o[1],0,0,0), C1,12); \
    }while(0)
  int t=1;
  #undef CMASK
  #define CMASK(P0,P1,t) do{}while(0)
  for(;t+5<NT;t+=2){
    STEP(pB0,pB1,pA0,pA1,t,true,true,true);     WAIT_BAR(2); RESC(); ROT();
    STEP(pA0,pA1,pB0,pB1,t+1,true,true,true);   WAIT_BAR(2); RESC(); ROT();
  }
  #undef CMASK
  #define CMASK(P0,P1,t) do{int jb_=(t)-(NT-4); if(jb_>=0)cmask(P0,P1,jb_,qrel,hi);}while(0)
  #define ENDW(tt) do{ if((tt)+3<NT){WAIT_BAR(2);} else if((tt)+2<NT){WAIT_BAR(1);} else {WAIT_BAR(0);} }while(0)
  for(;t+1<NT;t+=2){
    STEP(pB0,pB1,pA0,pA1,t,(t+3<NT),(t+1<NT),(t+1<NT));       ENDW(t);   RESC(); ROT();
    STEP(pA0,pA1,pB0,pB1,t+1,(t+4<NT),(t+2<NT),(t+2<NT));     ENDW(t+1); RESC(); ROT();
  }
  STEP(pB0,pB1,pA0,pA1,NT-1,false,false,false); RESC();
  { float sacc=pB0[0]+pB0[1]; _Pragma("unroll") for(int r=2;r<16;++r)sacc+=pB0[r]; _Pragma("unroll") for(int r=0;r<16;++r)sacc+=pB1[r]; l_reg+=sacc;
    pw0=(u32x4){PKW(pB0,0),PKW(pB0,2),PKW(pB0,4),PKW(pB0,6)};pw1=(u32x4){PKW(pB0,8),PKW(pB0,10),PKW(pB0,12),PKW(pB0,14)};pw2=(u32x4){PKW(pB1,0),PKW(pB1,2),PKW(pB1,4),PKW(pB1,6)};pw3=(u32x4){PKW(pB1,8),PKW(pB1,10),PKW(pB1,12),PKW(pB1,14)};
    SBAR(); pv(o,vb0+sl_cur,PAF(0),PAF(1),PAF(2),PAF(3)); }
  #undef PKW
  #undef PAF
  #undef VFR
  #undef PIN
  #undef MX3
  #undef GAPA
  #undef GAPB
  #undef EX
  #undef VRD
  #undef KRD
  #undef STEP
  #undef ENDW
  {auto rr=__builtin_amdgcn_permlane32_swap(__float_as_uint(l_reg),__float_as_uint(l_reg),false,false);l_reg=__uint_as_float(rr[0])+__uint_as_float(rr[1]);}
  if(hi==0)wsf[32+r32]=l_reg;asm volatile("s_waitcnt lgkmcnt(0)":::"memory");
  float rli[16];
  #pragma unroll
  for(int r=0;r<16;++r)rli[r]=__builtin_amdgcn_rcpf(wsf[32+crow(r,hi)]);
  bf16*Ow=Oh+(long)(q0+wid*QBLK)*opitch;
  { bf16*stg=(bf16*)(shm+LDS_OST)+wid*2048;
    #pragma unroll
    for(int r=0;r<16;++r){const int orow=crow(r,hi);
      #pragma unroll
      for(int d0=0;d0<2;++d0)stg[orow*64+d0*32+r32]=__float2bfloat16(o[d0][r]*rli[r]);}
    asm volatile("s_waitcnt lgkmcnt(0)":::"memory");
    #pragma unroll
    for(int i=0;i<4;++i){const int row=i*8+(lane>>3),ch=lane&7; const u32x4 v=*(const u32x4*)(stg+row*64+ch*8); ATTN_STORE16(Ow+(long)row*opitch+ch*8,v);} }
  asm volatile("s_waitcnt lgkmcnt(0)\n\ts_barrier":::"memory");
  #undef DMA_K
  #undef DMA_V
  #undef CMASK
  #undef START
  #undef RESC
  #undef ROT
  #undef FBINIT
}
constexpr int ATTN_LDS_BYTES=LDS_BYTES;
#undef SBAR
#undef WAIT_BAR
}
namespace ret_body {
using bf16 = __hip_bfloat16;
using bf16x8 = __attribute__((ext_vector_type(8))) short;
using s16x4 = __attribute__((ext_vector_type(4))) short;
using f32x16 = __attribute__((ext_vector_type(16))) float;
using u32x4 = __attribute__((ext_vector_type(4))) unsigned;
typedef __attribute__((address_space(3))) const char* lds_cptr;
typedef short v4i16_t __attribute__((ext_vector_type(4)));
constexpr int PITCH = 512, QB = 256, KVBLK = 64, SLOT = 16384, LDS_K = 0, LDS_V = 2 * SLOT, LDS_BYTES = 4 * SLOT;
__device__ __forceinline__ int crow(int r, int hi) { return (r & 3) + 8 * (r >> 2) + 4 * hi; }
__device__ __forceinline__ unsigned cvtpk(float lo, float hi) { typedef float f2 __attribute__((ext_vector_type(2))); typedef __bf16 b2 __attribute__((ext_vector_type(2))); f2 v = {lo, hi}; b2 b = __builtin_convertvector(v, b2); return __builtin_bit_cast(unsigned, b); }
__device__ __forceinline__ s16x4 vtr(lds_cptr p) { return __builtin_bit_cast(s16x4, __builtin_amdgcn_ds_read_tr16_b64_v4i16((__attribute__((address_space(3))) v4i16_t*)p)); }
__device__ __forceinline__ float half_sum(float v) { v += __shfl_xor(v, 1); v += __shfl_xor(v, 2); v += __shfl_xor(v, 4); v += __shfl_xor(v, 8); v += __shfl_xor(v, 16); return v; }

__device__ __forceinline__ void ret_unit(int qb, const bf16* Qh, const bf16* __restrict__ Kh, const bf16* __restrict__ Vh, const bf16* __restrict__ Gh, bf16* Oh, int opitch, float lg2, __attribute__((address_space(3))) unsigned char* shm) {
    int tid_ = threadIdx.x; asm volatile("" : "+v"(tid_)); const int tid = tid_, lane = tid & 63, r32 = lane & 31, hi = lane >> 5; const int wid = __builtin_amdgcn_readfirstlane(tid >> 6);
    const int q0 = qb * QB; const int NT = (q0 + QB) / KVBLK;
    const bf16* Qw = Qh + (long)(q0 + wid * 32) * PITCH;
    const bf16* ksrc = Kh + (long)lane * PITCH + wid * 8;
    const bf16* vsrc0 = Vh + (long)(16 * (wid & 3) + (lane >> 2)) * PITCH + (wid >> 2) * 32 + (lane & 3) * 8;
    const bf16* vsrc1 = vsrc0 + 64;
#define RET_LOAD(t, s) do { const long go_ = (long)(t) * KVBLK * PITCH; \
        __builtin_amdgcn_global_load_lds((const unsigned*)(ksrc + go_), (__attribute__((address_space(3))) unsigned*)(shm + LDS_K + (s) * SLOT + wid * 1024), 16, 0, 0); \
        __builtin_amdgcn_global_load_lds((const unsigned*)(ksrc + go_ + 64), (__attribute__((address_space(3))) unsigned*)(shm + LDS_K + (s) * SLOT + (wid + 8) * 1024), 16, 0, 0); \
        __builtin_amdgcn_global_load_lds((const unsigned*)(vsrc0 + go_), (__attribute__((address_space(3))) unsigned*)(shm + LDS_V + (s) * SLOT + wid * 1024), 16, 0, 0); \
        __builtin_amdgcn_global_load_lds((const unsigned*)(vsrc1 + go_), (__attribute__((address_space(3))) unsigned*)(shm + LDS_V + (s) * SLOT + 8192 + wid * 1024), 16, 0, 0); } while (0)
    RET_LOAD(0, 0);
    bf16x8 qr[8];
#pragma unroll
    for (int d0 = 0; d0 < 8; ++d0) qr[d0] = *reinterpret_cast<const bf16x8*>(&Qw[(long)r32 * PITCH + d0 * 16 + hi * 8]);
    f32x16 o[4];
#pragma unroll
    for (int d = 0; d < 4; ++d) o[d] = f32x16{};
    const float tq = (float)(q0 + wid * 32 + r32);
    const int kvl = (int)((lane >> 4) & 1) * 32 + (lane & 3) * 8 + (4 * hi + ((lane & 15) >> 2)) * 64;
    for (int t = 0; t < NT; ++t) {
        asm volatile("s_waitcnt vmcnt(0)" ::: "memory");
        __syncthreads();
        if (t + 1 < NT) RET_LOAD(t + 1, (t + 1) & 1);
        const lds_cptr Ks = (lds_cptr)(shm + LDS_K + (t & 1) * SLOT), Vs = (lds_cptr)(shm + LDS_V + (t & 1) * SLOT);
        f32x16 p0 = f32x16{}, p1 = f32x16{};
#pragma unroll
        for (int d0 = 0; d0 < 8; ++d0) {
            const bf16x8 k0 = *(const __attribute__((address_space(3))) bf16x8*)(Ks + (2 * d0 + hi) * 1024 + r32 * 16);
            const bf16x8 k1 = *(const __attribute__((address_space(3))) bf16x8*)(Ks + (2 * d0 + hi) * 1024 + 512 + r32 * 16);
            p0 = __builtin_amdgcn_mfma_f32_32x32x16_bf16(k0, qr[d0], p0, 0, 0, 0);
            p1 = __builtin_amdgcn_mfma_f32_32x32x16_bf16(k1, qr[d0], p1, 0, 0, 0);
        }
        const float dbase = tq - (float)(64 * t + 4 * hi);
#pragma unroll
        for (int r = 0; r < 16; ++r) {
            const float d0 = dbase - (float)((r & 3) + 8 * (r >> 2)), d1 = d0 - 32.0f;
            p0[r] = d0 >= 0.f ? p0[r] * __builtin_amdgcn_exp2f(lg2 * d0) : 0.f;
            p1[r] = d1 >= 0.f ? p1[r] * __builtin_amdgcn_exp2f(lg2 * d1) : 0.f;
        }
        u32x4 pw[4];
#pragma unroll
        for (int j = 0; j < 4; ++j) { pw[0][j] = cvtpk(p0[2 * j], p0[2 * j + 1]); pw[1][j] = cvtpk(p0[8 + 2 * j], p0[8 + 2 * j + 1]); pw[2][j] = cvtpk(p1[2 * j], p1[2 * j + 1]); pw[3][j] = cvtpk(p1[8 + 2 * j], p1[8 + 2 * j + 1]); }
#pragma unroll
        for (int d = 0; d < 4; ++d)
#pragma unroll
            for (int ks = 0; ks < 4; ++ks) {
                const s16x4 lo = vtr(Vs + d * 4096 + ks * 1024 + kvl), hh = vtr(Vs + d * 4096 + ks * 1024 + 512 + kvl);
                const bf16x8 vf = (bf16x8){lo[0], lo[1], lo[2], lo[3], hh[0], hh[1], hh[2], hh[3]};
                o[d] = __builtin_amdgcn_mfma_f32_32x32x16_bf16(__builtin_bit_cast(bf16x8, pw[ks]), vf, o[d], 0, 0, 0);
            }
    }
#undef RET_LOAD
    const long rbase = (long)(q0 + wid * 32);
#pragma unroll
    for (int r = 0; r < 16; ++r) {
        const float s = half_sum((o[0][r] + o[1][r]) + (o[2][r] + o[3][r])); const float mu = s * (1.0f / 128.0f);
        float q = 0.f;
#pragma unroll
        for (int d = 0; d < 4; ++d) { const float e = o[d][r] - mu; q += e * e; }
        q = half_sum(q); const float rstd = 1.0f / sqrtf(q * (1.0f / 128.0f) + 1e-5f);
        const long ro = (rbase + crow(r, hi)) * PITCH, oo = (rbase + crow(r, hi)) * opitch;
#pragma unroll
        for (int d = 0; d < 4; ++d) { const float g = __bfloat162float(Gh[ro + 32 * d + r32]); Oh[oo + 32 * d + r32] = __float2bfloat16((o[d][r] - mu) * rstd * g); }
    }
    __syncthreads();
}
}
constexpr int NWAVES = 8;
#ifndef MK_N_LAUNCHES
#define MK_N_LAUNCHES 1
#endif
constexpr int NB = 16, SEQ = 2048, DM = 1024, NTOK = NB * SEQ, DEPTH = 2;
constexpr int IN_COLS = 8200, NE = 32, TOPK = 4;
constexpr int NSLOT = NTOK * TOPK, MAXROWS = NSLOT + NE * 256, MAXTILES = MAXROWS / 256;
constexpr float NORM_EPS = 1e-5f, LOG2E = 1.4426950408889634f;
constexpr int PH_PER_LAYER = 10, N_PHASES = 2 + DEPTH * PH_PER_LAYER;
constexpr int N_LAUNCHES = (MK_N_LAUNCHES == 1) ? 1 : N_PHASES;
constexpr size_t MiB = 1u << 20;
constexpr size_t WS_CTL = 0, CTL_ZERO_BYTES = 1 * MiB;
constexpr size_t WS_MOD = 1 * MiB, WS_ROPE = 2 * MiB, WS_BUP = 3 * MiB, WS_LOGF = 4 * MiB, WS_FB = 5 * MiB;
constexpr size_t WS_SLOT_E = 11 * MiB, WS_SLOT_LP = 11 * MiB + 512 * 1024, WS_TOPW = 12 * MiB, WS_LCNT = 12 * MiB + 512 * 1024, WS_OFFS = WS_LCNT + 64 * 1024, WS_TILE_E = WS_OFFS + 4096;
constexpr size_t WS_SROW = 13 * MiB, WS_ROWW = 14 * MiB;
constexpr size_t WS_WIN = 16 * MiB, WS_WBR = 48 * MiB, WS_WOUT = 54 * MiB, WS_WUP = 64 * MiB, WS_WDN = 320 * MiB;
constexpr size_t SZ_WIN = 16 * MiB, SZ_WBR = 3 * MiB, SZ_WOUT = 2 * MiB, SZ_WUP = 128 * MiB, SZ_WDN = 64 * MiB;
constexpr size_t WS_H = 448 * MiB, WS_XR = 512 * MiB;
constexpr size_t WS_PROJ = 640 * MiB, WS_GATES = 960 * MiB, WS_A12 = 1152 * MiB, WS_OBR = 1216 * MiB, WS_MF32 = 1312 * MiB, WS_MERGED = 1440 * MiB;
constexpr size_t WS_XG = 640 * MiB, WS_ACT = 912 * MiB, WS_Y = 1184 * MiB;
constexpr size_t WS_END = 1504 * MiB;
constexpr size_t SZ_T512 = (size_t)NTOK * 512 * 2;
static_assert(WS_Y + (size_t)NSLOT * 1024 * 2 <= WS_MERGED && WS_ACT + (size_t)MAXROWS * 1024 * 2 <= WS_Y && WS_XG + (size_t)MAXROWS * 1024 * 2 <= WS_ACT, "MoE overlay");
static_assert(WS_SROW + MAXROWS * 4 <= WS_ROWW && WS_ROWW + MAXROWS * 4 <= WS_WIN && WS_TILE_E + 4096 <= WS_SROW, "small tables");
constexpr int CW_TMO = 0, CW_BAR = 4096;
constexpr int RING_OFF = 0, RING_BYTES = 131072;
constexpr int LDSCTL_OFF = RING_BYTES, MISC_OFF = LDSCTL_OFF + 320;
constexpr int LDS_BYTES = 147456;
static_assert(attn_body::ATTN_LDS_BYTES <= RING_BYTES && ret_body::LDS_BYTES <= RING_BYTES, "phase LDS");

#define GAS __attribute__((address_space(1)))
#define LAS __attribute__((address_space(3)))
typedef unsigned short bf16;
typedef unsigned v4u __attribute__((ext_vector_type(4)));
typedef float f32x4 __attribute__((ext_vector_type(4)));
typedef short bf16x8 __attribute__((ext_vector_type(8)));
typedef GAS unsigned gu32;
typedef GAS unsigned long long gu64;
#define RLX_AGENT __ATOMIC_RELAXED, __HIP_MEMORY_SCOPE_AGENT
#define LDS_WAIT() asm volatile("s_waitcnt lgkmcnt(0)" ::: "memory")
#define VM_WAIT() asm volatile("s_waitcnt vmcnt(0)" ::: "memory")
__device__ __forceinline__ unsigned long long rt() { return __builtin_amdgcn_s_memrealtime(); }
__device__ __forceinline__ unsigned f2bf(float f) { unsigned u = __builtin_bit_cast(unsigned, f); return (u + 0x7fffu + ((u >> 16) & 1u)) >> 16; }
__device__ __forceinline__ unsigned pk2(float lo, float hi) { return f2bf(lo) | (f2bf(hi) << 16); }

#define XB_TMO      128
#define XB_XCNT(j)  (256  + 64 * (j))
#define XB_XSUB(j)  (1280 + 64 * (j))
#define XB_XGEN(j)  (2304 + 64 * (j))
#define XB_TOP      3328
#define XB_TOPGEN   3392
#define XCD_BAR_WORDS 3456
#define XB_SPIN_CAP (1u << 18)

__device__ __forceinline__ unsigned xb_ld(unsigned* p)              { return __hip_atomic_load(p, __ATOMIC_RELAXED, __HIP_MEMORY_SCOPE_AGENT); }
__device__ __forceinline__ unsigned xb_add(unsigned* p, unsigned v) { return __hip_atomic_fetch_add(p, v, __ATOMIC_RELAXED, __HIP_MEMORY_SCOPE_AGENT); }
__device__ __forceinline__ unsigned xb_xcc_id() { return (unsigned)__builtin_amdgcn_s_getreg((3 << 11) | 20) & 0xFu; }
#define XB_SPIN(cond, bar) do { unsigned _sp = 0; while (cond) { __builtin_amdgcn_s_sleep(1); \
    if ((++_sp & 255u) == 0u) { if (xb_ld(&(bar)[XB_TMO])) break; if (_sp > XB_SPIN_CAP) { atomicAdd(&(bar)[XB_TMO], 1u); break; } } } } while (0)

struct XcdBarrier {
    unsigned* bar; unsigned x;
    volatile LAS unsigned* st;
};

__device__ __forceinline__ XcdBarrier xcd_barrier_post(unsigned* bar, volatile LAS unsigned* st) {
    XcdBarrier b; b.bar = bar; b.x = xb_xcc_id(); b.st = st;
    if (threadIdx.x == 0) (void)xb_add(&bar[XB_XCNT(b.x)], 1u);
    return b;
}
__device__ __forceinline__ void xcd_barrier_complete(unsigned* bar, unsigned x, unsigned& nloc, unsigned& nx) {
    const unsigned G = gridDim.x * gridDim.y * gridDim.z;
    unsigned sum, cnt, mine, sp = 0u;
    for (;;) {
        sum = 0u; cnt = 0u; mine = 0u;
#pragma unroll
        for (unsigned j = 0; j < 16; ++j) { const unsigned c = xb_ld(&bar[XB_XCNT(j)]); sum += c; cnt += (c > 0u) ? 1u : 0u; mine = (j == x) ? c : mine; }
        if (sum == G) break;
        __builtin_amdgcn_s_sleep(1);
        if ((++sp & 255u) == 0u) { if (xb_ld(&bar[XB_TMO])) break; if (sp > XB_SPIN_CAP) { atomicAdd(&bar[XB_TMO], 1u); break; } }
    }
    nloc = mine > 0u ? mine : 1u; nx = cnt > 0u ? cnt : 1u;
}

__device__ __forceinline__ void xcd_barrier(const XcdBarrier& b) {
    asm volatile("s_waitcnt vmcnt(0)" ::: "memory");
    __syncthreads();
    if (threadIdx.x == 0) {
        unsigned* bar = b.bar;
        __builtin_amdgcn_s_waitcnt(0);
        unsigned nloc = b.st[0], nx = b.st[1];
        if (nloc == 0u) { xcd_barrier_complete(bar, b.x, nloc, nx); b.st[0] = nloc; b.st[1] = nx; }
        const unsigned old = xb_add(&bar[XB_XSUB(b.x)], 1u);
        const unsigned gen = old / nloc;
        if (old + 1u == (gen + 1u) * nloc) {
            __builtin_amdgcn_fence(__ATOMIC_RELEASE, "agent");
            asm volatile("s_waitcnt vmcnt(0)" ::: "memory");
            const unsigned og = xb_add(&bar[XB_TOP], 1u);
            const unsigned tg = og / nx;
            if (og + 1u == (tg + 1u) * nx) xb_add(&bar[XB_TOPGEN], 1u);
            else XB_SPIN(xb_ld(&bar[XB_TOPGEN]) == tg, bar);
            __builtin_amdgcn_fence(__ATOMIC_ACQUIRE, "agent");
            xb_add(&bar[XB_XGEN(b.x)], 1u);
            asm volatile("s_waitcnt vmcnt(0)" ::: "memory");
        } else {
            XB_SPIN(xb_ld(&bar[XB_XGEN(b.x)]) == gen, bar);
            __builtin_amdgcn_fence(__ATOMIC_ACQUIRE, "agent");
            asm volatile("s_waitcnt vmcnt(0)" ::: "memory");
        }
    }
    __syncthreads();
}


struct Frame {
    LAS unsigned char* lds;
    volatile LAS unsigned* MISC;
    gu32* ctl;
    int tid, lane, wave, vcu, G, bx;
    unsigned char* ws;
};
constexpr int PT_OFF = LDSCTL_OFF + 1024, PT_OUT = 23, PT_WS = 24;
__device__ __forceinline__ unsigned long long ptr_ld(const Frame& F, int i) {
    const unsigned ad = (unsigned)(uintptr_t)F.lds + PT_OFF + 8 * i; unsigned tmp; unsigned long long v;
    asm volatile("v_mov_b32 %0, %2\n\tds_read_b64 %1, %0\n\ts_waitcnt lgkmcnt(0)" : "=&v"(tmp), "=v"(v) : "s"(ad) : "memory");
    const unsigned lo = __builtin_amdgcn_readfirstlane((unsigned)v), hi = __builtin_amdgcn_readfirstlane((unsigned)(v >> 32));
    return ((unsigned long long)hi << 32) | lo;
}
#define IP(i) ((const float*)(const GAS float*)ptr_ld(F, (i)))
#define WSP() ((unsigned char*)(GAS unsigned char*)ptr_ld(F, PT_WS))
__device__ __forceinline__ float wave_sum(float v) {
#pragma unroll
    for (int o = 1; o < 64; o <<= 1) v += __shfl_xor(v, o);
    return v;
}
__device__ __forceinline__ float bf_lo(unsigned u) { return __builtin_bit_cast(float, u << 16); }
__device__ __forceinline__ float bf_hi(unsigned u) { return __builtin_bit_cast(float, u & 0xffff0000u); }

struct MapId { __device__ __forceinline__ int operator()(int n) const { return n; } };
struct MapIn { __device__ __forceinline__ int operator()(int n) const {
    if (n < 1536) return n;
    if (n < 2560) { const int seg = n - 1536, p = seg >> 8, w = seg & 255, hl = w >> 7, hf = (w >> 6) & 1, i = w & 63; return 1536 + p * 256 + hf * 128 + hl * 64 + i; }
    if (n < 5120) return n;
    if (n < 5128) return -1;
    return n - 8; } };
struct MapUp { __device__ __forceinline__ int operator()(int n) const { const int j = n >> 1; return (j >> 7) * 256 + (n & 1) * 128 + (j & 127); } };
template <class Map> __device__ __forceinline__ void p0_transpose_item(const float* W, int K, int Nsrc, bf16* WT, Map map, LAS float* scr, int item, int lane, int ldk = 0, int koff = 0) {
    const int nblk = (Nsrc + 31) / 32, kb = item / nblk, nb = item % nblk, k0 = 64 * kb, n0 = 32 * nb;
    const int nr = n0 + (lane & 31); const bool okr = nr < Nsrc;
#pragma unroll 8
    for (int i = 0; i < 32; ++i) { const int kk = 2 * i + (lane >> 5); scr[kk * 33 + (lane & 31)] = okr ? W[(size_t)(k0 + kk) * Nsrc + nr] : 0.f; }
    LDS_WAIT(); asm volatile("" ::: "memory");
    const int c = lane & 7;
#pragma unroll
    for (int j = 0; j < 4; ++j) { const int n = (lane >> 3) + 8 * j; const LAS float* s = scr + (8 * c) * 33 + n; const int dr = (n0 + n < Nsrc) ? map(n0 + n) : -1;
        v4u o; o.x = pk2(s[0 * 33], s[1 * 33]); o.y = pk2(s[2 * 33], s[3 * 33]); o.z = pk2(s[4 * 33], s[5 * 33]); o.w = pk2(s[6 * 33], s[7 * 33]);
        if (dr >= 0) *(GAS v4u*)(WT + (size_t)dr * (ldk ? ldk : K) + koff + k0 + 8 * c) = o; }
    LDS_WAIT(); asm volatile("" ::: "memory");
}
constexpr int IT_IN = 16 * 257, IT_BR = 3 * 8 * 32, IT_OUT = 16 * 32, IT_UP = NE * 16 * 64, IT_DN = NE * 16 * 32, IT_LAYER = IT_IN + IT_BR + IT_OUT + IT_UP + IT_DN;

struct Ins {
    const float *x, *c, *norm1_g, *norm2_g, *ada_w, *ada_b, *w_in, *gate_b, *fox_fb, *lam_q1, *lam_k1, *lam_q2, *lam_k2, *subln_g, *w_branch, *w_out, *router_w, *router_b, *w_up, *b_up, *w_down, *b_down, *final_g;
};

__device__ __forceinline__ void p0_prologue(Frame& F) {
    const int gw = F.vcu * NWAVES + F.wave, NGW = F.G * NWAVES; unsigned char* const wsl = WSP();
    {
        LAS float* sc = (LAS float*)(F.lds + RING_OFF);
        LAS float* red = (LAS float*)(F.lds + RING_OFF + 65536);
        bool filled = false;
        for (int it = F.vcu; it < DEPTH * 96; it += F.G) {
            if (!filled) { for (int idx = F.tid; idx < NB * DM; idx += NWAVES * 64) { const int b = idx >> 10, k = idx & 1023; const float v = IP(1  )[idx]; sc[k * 16 + b] = v / (1.0f + __expf(-v)); } filled = true; }
            __syncthreads();
            const int l = it / 96, cb = it % 96; const float* W = IP(4  ) + (size_t)l * DM * 6144 + cb * 64 + F.lane;
            float acc[16];
#pragma unroll
            for (int b = 0; b < 16; ++b) acc[b] = 0.f;
            for (int k = F.wave * 128; k < F.wave * 128 + 128; ++k) { const float w = W[(size_t)k * 6144];
#pragma unroll
                for (int q = 0; q < 4; ++q) { const f32x4 s4 = *(const LAS f32x4*)(sc + k * 16 + 4 * q); acc[4 * q] += s4[0] * w; acc[4 * q + 1] += s4[1] * w; acc[4 * q + 2] += s4[2] * w; acc[4 * q + 3] += s4[3] * w; } }
#pragma unroll
            for (int b = 0; b < 16; ++b) red[(F.wave * 16 + b) * 64 + F.lane] = acc[b];
            __syncthreads();
            for (int o = F.tid; o < 1024; o += NWAVES * 64) { const int b = o >> 6, col = o & 63; float s = IP(5  )[l * 6144 + cb * 64 + col];
#pragma unroll
                for (int w = 0; w < 8; ++w) s += red[(w * 16 + b) * 64 + col];
                ((float*)(wsl + WS_MOD))[(size_t)(l * 16 + b) * 6144 + cb * 64 + col] = s; }
        }
        __syncthreads();
    }
    {
        float* rope = (float*)(wsl + WS_ROPE);
        for (int idx = (F.vcu * NWAVES * 64) + F.tid; idx < SEQ * 64; idx += F.G * NWAVES * 64) { const int pos = idx >> 6, i = idx & 63;
            const float inv = (float)exp2(-(double)i * (13.287712379549449 / 64.0));
            const float ang = (float)pos * inv; const double rev = (double)ang * 0.15915494309189535; const float fr = (float)(rev - rint(rev));
            rope[2 * idx] = __builtin_amdgcn_cosf(fr); rope[2 * idx + 1] = __builtin_amdgcn_sinf(fr); }
        float* bup = (float*)(wsl + WS_BUP); MapUp mu;
        for (int idx = (F.vcu * NWAVES * 64) + F.tid; idx < DEPTH * NE * 2048; idx += F.G * NWAVES * 64) { const int n = idx & 2047, le = idx >> 11; bup[(size_t)le * 2048 + mu(n)] = IP(19  )[idx]; }
    }
    LAS float* scr = (LAS float*)(F.lds + RING_OFF + F.wave * 16384);
    for (int it = gw; it < DEPTH * IT_LAYER; it += NGW) {
        const int l = it / IT_LAYER; int r = it % IT_LAYER;
        if (r < IT_IN) { p0_transpose_item(IP(6  ) + (size_t)l * DM * IN_COLS, DM, IN_COLS, (bf16*)(wsl + WS_WIN + l * SZ_WIN), MapIn(), scr, r, F.lane); continue; } r -= IT_IN;
        if (r < IT_BR) { const int b = r / 256; p0_transpose_item(IP(14  ) + ((size_t)l * 3 + b) * 512 * DM, 512, DM, (bf16*)(wsl + WS_WBR + l * SZ_WBR), MapId(), scr, r % 256, F.lane, 1536, b * 512); continue; } r -= IT_BR;
        if (r < IT_OUT) { p0_transpose_item(IP(15  ) + (size_t)l * DM * DM, DM, DM, (bf16*)(wsl + WS_WOUT + l * SZ_WOUT), MapId(), scr, r, F.lane); continue; } r -= IT_OUT;
        if (r < IT_UP) { const int e = r / 1024; p0_transpose_item(IP(18  ) + ((size_t)l * NE + e) * DM * 2048, DM, 2048, (bf16*)(wsl + WS_WUP + l * SZ_WUP) + (size_t)e * 2048 * DM, MapUp(), scr, r % 1024, F.lane); continue; } r -= IT_UP;
        { const int e = r / 512; p0_transpose_item(IP(20  ) + ((size_t)l * NE + e) * DM * DM, DM, DM, (bf16*)(wsl + WS_WDN + l * SZ_WDN) + (size_t)e * DM * DM, MapId(), scr, r % 512, F.lane); }
    }
}

constexpr int TL_RS = 0, TL_BP = 512, TL_PART = 4096, TL_HIST = 40960, TL_BASE = 41216, TL_ROWOF = 41472;
template <bool UPD> __device__ __forceinline__ void norm_block(Frame& F, int blk, const float* xin, float* xr, const bf16* Y, const float* g2, const float* gain, const float* modl, int i_sh, int i_sc, bf16* H) {
    LAS float* rs = (LAS float*)(F.lds + TL_RS);
    for (int r = 0; r < 16; ++r) {
        const int row = blk * 128 + F.wave * 16 + r, b = row >> 11;
        f32x4 v[4];
#pragma unroll
        for (int j = 0; j < 4; ++j) v[j] = *(const f32x4*)(xin + (size_t)row * DM + 4 * (64 * j + F.lane));
        if (UPD) {
#pragma unroll
            for (int j = 0; j < 4; ++j) { const int c = 4 * (64 * j + F.lane); f32x4 a = {0.f, 0.f, 0.f, 0.f};
#pragma unroll
                for (int k = 0; k < 4; ++k) { const uint2 y = *(const uint2*)(Y + ((size_t)row * 4 + k) * DM + c); a[0] += bf_lo(y.x); a[1] += bf_hi(y.x); a[2] += bf_lo(y.y); a[3] += bf_hi(y.y); }
                const f32x4 g = *(const f32x4*)(g2 + (size_t)b * 6144 + c); v[j] += g * a; *(f32x4*)(xr + (size_t)row * DM + c) = v[j]; }
        }
        float ss = 0.f;
#pragma unroll
        for (int j = 0; j < 4; ++j) ss += (v[j][0] * v[j][0] + v[j][1] * v[j][1]) + (v[j][2] * v[j][2] + v[j][3] * v[j][3]);
        const float rstd = 1.0f / sqrtf(wave_sum(ss) * (1.0f / DM) + NORM_EPS);
        if (F.lane == 0) rs[F.wave * 16 + r] = rstd;
#pragma unroll
        for (int j = 0; j < 4; ++j) { const int c = 4 * (64 * j + F.lane);
            const f32x4 gn = *(const f32x4*)(gain + c), sc = *(const f32x4*)(modl + (size_t)b * 6144 + i_sc * 1024 + c), sh = *(const f32x4*)(modl + (size_t)b * 6144 + i_sh * 1024 + c);
            const f32x4 h = (v[j] * rstd) * gn * (sc + 1.0f) + sh;
            uint2 o; o.x = pk2(h[0], h[1]); o.y = pk2(h[2], h[3]); *(uint2*)(H + (size_t)row * DM + c) = o; }
    }
}
__device__ __forceinline__ void proj_block(Frame& F, int blk, const float* xrows, const float* W, int wpitch, int ncols, const float* gain, const float* modl, int i_sh, int i_sc) {
    typedef float f32x16 __attribute__((ext_vector_type(16)));
    const int rb = F.wave & 3, kh2 = F.wave >> 2, i = F.lane & 31, kh = F.lane >> 5; const int b = (blk * 128) >> 11;
    const float* x0 = xrows + (size_t)(blk * 128 + rb * 32 + i) * DM; const float* scp = modl + (size_t)b * 6144 + i_sc * 1024; const float* shp = modl + (size_t)b * 6144 + i_sh * 1024;
    const bool wok = i < ncols; const float* Wc = W + (wok ? i : 0);
    f32x16 acc = {0.f, 0.f, 0.f, 0.f, 0.f, 0.f, 0.f, 0.f, 0.f, 0.f, 0.f, 0.f, 0.f, 0.f, 0.f, 0.f}; float bacc = 0.f;
    for (int c = 64 * kh2; c < 64 * kh2 + 64; ++c) { const int k0 = 8 * c + 4 * kh;
        const f32x4 a = *(const f32x4*)(x0 + k0), gn = *(const f32x4*)(gain + k0), sc = *(const f32x4*)(scp + k0), sh = *(const f32x4*)(shp + k0);
#pragma unroll
        for (int j = 0; j < 4; ++j) { const float wv = wok ? Wc[(size_t)(k0 + j) * wpitch] : 0.f; bacc += sh[j] * wv; acc = __builtin_amdgcn_mfma_f32_32x32x2f32(a[j], gn[j] * (1.0f + sc[j]) * wv, acc, 0, 0, 0); } }
    LAS float* part = (LAS float*)(F.lds + TL_PART) + F.wave * (32 * 33);
#pragma unroll
    for (int r = 0; r < 16; ++r) part[((r & 3) + 8 * (r >> 2) + 4 * kh) * 33 + i] = acc[r];
    ((LAS float*)(F.lds + TL_BP))[(F.wave * 2 + kh) * 32 + i] = bacc;
}
__device__ __forceinline__ float proj_logit(Frame& F, int t, int e) {
    const int rb = t >> 5, r = t & 31; const LAS float* part = (const LAS float*)(F.lds + TL_PART); const LAS float* bp = (const LAS float*)(F.lds + TL_BP);
    const float d = part[(rb * 32 + r) * 33 + e] + part[((rb + 4) * 32 + r) * 33 + e];
    const float bb = (bp[(rb * 2) * 32 + e] + bp[(rb * 2 + 1) * 32 + e]) + (bp[((rb + 4) * 2) * 32 + e] + bp[((rb + 4) * 2 + 1) * 32 + e]);
    return ((const LAS float*)(F.lds + TL_RS))[t] * d + bb;
}

__device__ __forceinline__ void diff_post(Frame& F, int l, float lam_init) {
    float d1 = IP(9  )[l * 64 + F.lane] * IP(10  )[l * 64 + F.lane], d2 = IP(11  )[l * 64 + F.lane] * IP(12  )[l * 64 + F.lane];
    const float lam = __expf(wave_sum(d1)) - __expf(wave_sum(d2)) + lam_init; const float osc = 1.0f - lam_init;
    unsigned char* const wsl = WSP();
    const bf16* A1 = (const bf16*)(wsl + WS_A12); const bf16* A2 = A1 + (size_t)NTOK * 512; bf16* O = (bf16*)(wsl + WS_OBR);
    const int c0 = 8 * F.lane; const float* gp = IP(13  ) + l * 128 + (c0 & 127);
    const f32x4 g0 = *(const f32x4*)gp, g1 = *(const f32x4*)(gp + 4);
    for (int row = F.vcu * NWAVES + F.wave; row < NTOK; row += F.G * NWAVES) {
        const v4u a = *(const v4u*)(A1 + (size_t)row * 512 + c0), bq = *(const v4u*)(A2 + (size_t)row * 512 + c0);
        float d[8]; const unsigned au[4] = {a.x, a.y, a.z, a.w}, bu[4] = {bq.x, bq.y, bq.z, bq.w};
#pragma unroll
        for (int q = 0; q < 4; ++q) { d[2 * q] = bf_lo(au[q]) - lam * bf_lo(bu[q]); d[2 * q + 1] = bf_hi(au[q]) - lam * bf_hi(bu[q]); }
        float ss = 0.f;
#pragma unroll
        for (int q = 0; q < 8; ++q) ss += d[q] * d[q];
        ss += __shfl_xor(ss, 1); ss += __shfl_xor(ss, 2); ss += __shfl_xor(ss, 4); ss += __shfl_xor(ss, 8);
        const float rr = osc / sqrtf(ss * (1.0f / 128.0f) + NORM_EPS);
        v4u o; o.x = pk2(d[0] * rr * g0[0], d[1] * rr * g0[1]); o.y = pk2(d[2] * rr * g0[2], d[3] * rr * g0[3]); o.z = pk2(d[4] * rr * g1[0], d[5] * rr * g1[1]); o.w = pk2(d[6] * rr * g1[2], d[7] * rr * g1[3]);
        *(v4u*)(O + (size_t)row * 1536 + c0) = o;
    }
}

struct Args { Ins in; float* out; unsigned char* ws; int ph_lo, ph_hi; };
__global__ void __launch_bounds__(NWAVES * 64, 2) mega_fwd(Args args) {
    extern __shared__ __attribute__((aligned(16))) unsigned char lds[];
    Frame F;
    F.lds = (LAS unsigned char*)lds;
    F.MISC = (volatile LAS unsigned*)(F.lds + MISC_OFF);
    F.tid = threadIdx.x; F.lane = F.tid & 63; F.wave = __builtin_amdgcn_readfirstlane(F.tid >> 6);
    F.G = gridDim.x; { const int bx = blockIdx.x; F.vcu = (F.G % 8 == 0) ? (bx % 8) * (F.G / 8) + bx / 8 : bx; }
    F.ctl = (gu32*)(args.ws + WS_CTL);
    for (int u = F.tid; u < (LDS_BYTES - LDSCTL_OFF) / 4; u += NWAVES * 64) ((LAS unsigned*)(F.lds + LDSCTL_OFF))[u] = 0u;
    if (F.tid == 0) { LAS unsigned long long* pt = (LAS unsigned long long*)(F.lds + PT_OFF);
#define PTW(i, f) pt[i] = (unsigned long long)args.in.f
        PTW(0, x); PTW(1, c); PTW(2, norm1_g); PTW(3, norm2_g); PTW(4, ada_w); PTW(5, ada_b); PTW(6, w_in); PTW(7, gate_b); PTW(8, fox_fb); PTW(9, lam_q1); PTW(10, lam_k1); PTW(11, lam_q2); PTW(12, lam_k2);
        PTW(13, subln_g); PTW(14, w_branch); PTW(15, w_out); PTW(16, router_w); PTW(17, router_b); PTW(18, w_up); PTW(19, b_up); PTW(20, w_down); PTW(21, b_down); PTW(22, final_g);
#undef PTW
        pt[PT_OUT] = (unsigned long long)args.out; pt[PT_WS] = (unsigned long long)args.ws; }
    __syncthreads();
    XcdBarrier bar; bar.bar = (unsigned*)(F.ctl + CW_BAR); bar.x = 0; bar.st = nullptr;
    if (N_LAUNCHES == 1) bar = xcd_barrier_post((unsigned*)(F.ctl + CW_BAR), F.MISC + 8);
#define GRID_BAR() do { if (N_LAUNCHES == 1) { XcdBarrier b2_ = bar; asm volatile("" : "+s"(b2_.bar), "+s"(b2_.x)); xcd_barrier(b2_); } } while (0)
    const int lo = args.ph_lo, hi = args.ph_hi;
#define IN(k) (N_LAUNCHES == 1 || (lo <= (k) && (k) < hi))
#ifndef EN_MASK
#define EN_MASK 0x7fff
#endif
#define EN(b) (((EN_MASK) >> (b)) & 1)
#ifndef REP_MASK
#define REP_MASK 0
#endif
#define NREP(b) (1 + (((REP_MASK) >> (b)) & 1))
#define SEAM(k) do { if (IN(k) && IN((k) + 1)) GRID_BAR(); } while (0)
#define PHASE_PTRS { int t_ = threadIdx.x, g_ = gridDim.x, bx_ = blockIdx.x; asm volatile("" : "+v"(t_), "+s"(g_), "+s"(bx_)); F.tid = t_; F.lane = t_ & 63; F.wave = __builtin_amdgcn_readfirstlane(t_ >> 6); F.G = g_; F.bx = bx_; F.vcu = (g_ % 8 == 0) ? (bx_ % 8) * (g_ / 8) + bx_ / 8 : bx_; } unsigned char* const ws = WSP(); float* const MOD = (float*)(ws + WS_MOD); float* const XR = (float*)(ws + WS_XR); bf16* const H = (bf16*)(ws + WS_H); bf16* const PROJ = (bf16*)(ws + WS_PROJ); \
    bf16* const GATES = (bf16*)(ws + WS_GATES); bf16* const OBR = (bf16*)(ws + WS_OBR); float* const LOGF = (float*)(ws + WS_LOGF); float* const FBT = (float*)(ws + WS_FB); \
    int* const SLOT_E = (int*)(ws + WS_SLOT_E); int* const SLOT_LP = (int*)(ws + WS_SLOT_LP); float* const TOPW = (float*)(ws + WS_TOPW); int* const LCNT = (int*)(ws + WS_LCNT); \
    int* const OFFS = (int*)(ws + WS_OFFS); int* const TILE_E = (int*)(ws + WS_TILE_E); int* const SROW = (int*)(ws + WS_SROW); float* const ROWW = (float*)(ws + WS_ROWW); \
    bf16* const XG = (bf16*)(ws + WS_XG); bf16* const ACT = (bf16*)(ws + WS_ACT); bf16* const YB = (bf16*)(ws + WS_Y); const float* const modl = MOD + (size_t)l * NB * 6144; \
    (void)XR; (void)H; (void)PROJ; (void)GATES; (void)OBR; (void)LOGF; (void)FBT; (void)SLOT_E; (void)SLOT_LP; (void)TOPW; (void)LCNT; (void)OFFS; (void)TILE_E; (void)SROW; (void)ROWW; (void)XG; (void)ACT; (void)YB; (void)modl
    if (EN(0) && IN(0)) for (int rep_ = 0; rep_ < NREP(0); ++rep_) { { int t_ = threadIdx.x, g_ = gridDim.x, bx_ = blockIdx.x; asm volatile("" : "+v"(t_), "+s"(g_), "+s"(bx_)); F.tid = t_; F.lane = t_ & 63; F.wave = __builtin_amdgcn_readfirstlane(t_ >> 6); F.G = g_; F.bx = bx_; F.vcu = (g_ % 8 == 0) ? (bx_ % 8) * (g_ / 8) + bx_ / 8 : bx_; } p0_prologue(F); }
    SEAM(0);

#ifndef DBG_LAYERS
#define DBG_LAYERS DEPTH
#endif
#ifndef DBG_SEL
#define DBG_SEL 7
#endif
#ifndef DBG_OUT
#define DBG_OUT 0
#endif
    if (0 < DBG_LAYERS) { constexpr int l = 0;

        const int P = 1 + l * PH_PER_LAYER;
        const float lam_init = (l == 0) ? 0.2f : 0.35550906759096926f;
        if (EN(1) && IN(P + 0)) for (int rep_ = 0; rep_ < ((l == 0) ? NREP(1) : 1); ++rep_) { PHASE_PTRS;
            for (int blk = F.vcu; blk < NTOK / 128; blk += F.G) {
                if (l == 0) norm_block<false>(F, blk, IP(0  ), nullptr, nullptr, nullptr, IP(2  ) + l * DM, modl, 0, 1, H);
                else        norm_block<true>(F, blk, XR, XR, YB, MOD + (size_t)(l - 1) * NB * 6144 + 5 * 1024, IP(2  ) + l * DM, modl, 0, 1, H);
                asm volatile("s_waitcnt vmcnt(0)" ::: "memory"); __syncthreads(); __builtin_amdgcn_fence(__ATOMIC_ACQUIRE, "agent");
                proj_block(F, blk, (l == 0) ? IP(0  ) : (const float*)XR, IP(6  ) + (size_t)l * DM * IN_COLS + 5120, IN_COLS, 8, IP(2  ) + l * DM, modl, 0, 1);
                __syncthreads();
                if (F.tid < 128) { const int row = blk * 128 + F.tid;
#pragma unroll
                    for (int e = 0; e < 8; ++e) { const float z = proj_logit(F, F.tid, e) + IP(8  )[l * 8 + e];
                        const float az = __builtin_fabsf(z); const float sp = 0.6931471805599453f * __builtin_amdgcn_logf(1.0f + __builtin_amdgcn_exp2f(-az * LOG2E));
                        LOGF[(size_t)row * 8 + e] = __builtin_fminf(z, 0.f) - sp; } }
                __syncthreads();
            }
        }
        SEAM(P + 0);
        if (EN(2) && IN(P + 1)) for (int rep_ = 0; rep_ < NREP(2); ++rep_) { PHASE_PTRS;
            LAS float* wtot = (LAS float*)(F.lds + MISC_OFF + 256);
            for (int j = F.vcu; j < NB * 8; j += F.G) {
                const int b = j >> 3, hh = j & 7; float v[4]; float run = 0.f;
#pragma unroll
                for (int q = 0; q < 4; ++q) { run += LOGF[((size_t)b * SEQ + 4 * F.tid + q) * 8 + hh]; v[q] = run; }
                float inc = run;
#pragma unroll
                for (int o = 1; o < 64; o <<= 1) { const float nb = __shfl_up(inc, o); if (F.lane >= o) inc += nb; }
                if (F.lane == 63) wtot[F.wave] = inc;
                __syncthreads();
                float base = inc - run;
                for (int w = 0; w < F.wave; ++w) base += wtot[w];
#pragma unroll
                for (int q = 0; q < 4; ++q) FBT[((size_t)b * 8 + hh) * SEQ + 4 * F.tid + q] = -LOG2E * (base + v[q]);
                __syncthreads();
            }
            pg8::Gemm g{(const pg8::bf16_t*)H, (const pg8::bf16_t*)(ws + WS_WIN + l * SZ_WIN), NTOK, 8192, DM, 0};
            pg8::StaticOrder S; S.init(NTOK, 8192, F.G, F.bx);
            pg8::EpiInProj E{(pg8::bf16_t*)PROJ, (pg8::bf16_t*)GATES, IP(7  ) + l * 3072, (const float*)(ws + WS_ROPE)};
            pg8::gemm_phase<pg8::EpiInProj, pg8::StaticOrder, true, true>(F.lds + RING_OFF, g, S, E);
        }
        SEAM(P + 1);
        if (EN(3) && IN(P + 2)) for (int rep_ = 0; rep_ < NREP(3); ++rep_) { PHASE_PTRS;
            using abf = attn_body::bf16;
            if (EN(12)) for (int rr_ = 0; rr_ < NREP(12); ++rr_) for (int j = F.vcu; j < NB * 8 * 4; j += F.G) { const int bh = j >> 2, s = j & 3, b = bh >> 3, hh = bh & 7; const size_t ro = (size_t)b * SEQ * 512 + hh * 64;
                const abf* Q = (const abf*)(PROJ + 7 * (size_t)NTOK * 512) + ro; const abf* K = (const abf*)(PROJ + 8 * (size_t)NTOK * 512) + ro; const abf* V = (const abf*)(PROJ + 9 * (size_t)NTOK * 512) + ro;
                abf* O = (abf*)OBR + (size_t)b * SEQ * 1536 + 1024 + hh * 64; const float* fb = FBT + ((size_t)b * 8 + hh) * SEQ;
                attn_body::attn_unit<8, true>(7 - s, Q, K, V, O, 1536, fb, (char*)lds + RING_OFF);
                attn_body::attn_unit<8, true>(s, Q, K, V, O, 1536, fb, (char*)lds + RING_OFF); }
            if (EN(13)) for (int rr_ = 0; rr_ < NREP(13); ++rr_) for (int j = F.vcu; j < NB * 16 * 4; j += F.G) { const int bv = j >> 2, s = j & 3, b = bv >> 4, v = bv & 15, h = v >> 2, m = (v >> 1) & 1, vh = v & 1; const size_t rb = (size_t)b * SEQ * 512;
                const abf* Q = (const abf*)(PROJ) + rb + h * 128 + m * 64; const abf* K = (const abf*)(PROJ + 1 * (size_t)NTOK * 512) + rb + h * 128 + m * 64; const abf* V = (const abf*)(PROJ + 2 * (size_t)NTOK * 512) + rb + h * 128 + vh * 64;
                abf* O = (abf*)(ws + WS_A12) + (size_t)m * NTOK * 512 + rb + h * 128 + vh * 64;
                attn_body::attn_unit<8, false>(7 - s, Q, K, V, O, 512, nullptr, (char*)lds + RING_OFF);
                attn_body::attn_unit<8, false>(s, Q, K, V, O, 512, nullptr, (char*)lds + RING_OFF); }
            if (EN(14)) for (int rr_ = 0; rr_ < NREP(14); ++rr_) for (int j = F.vcu; j < NB * 4 * 4; j += F.G) { const int bh = j >> 2, s = j & 3, b = bh >> 2, hh = bh & 3; const size_t ro = (size_t)b * SEQ * 512 + hh * 128;
                const abf* Q = (const abf*)(PROJ + 3 * (size_t)NTOK * 512) + ro; const abf* K = (const abf*)(PROJ + 4 * (size_t)NTOK * 512) + ro; const abf* V = (const abf*)(PROJ + 5 * (size_t)NTOK * 512) + ro;
                const abf* Gt = (const abf*)(PROJ + 6 * (size_t)NTOK * 512) + ro; abf* O = (abf*)OBR + (size_t)b * SEQ * 1536 + 512 + hh * 128;
                const float lg2 = log2f(1.0f - exp2f(-5.0f - (float)hh));
                ret_body::ret_unit(7 - s, Q, K, V, Gt, O, 1536, lg2, F.lds + RING_OFF);
                ret_body::ret_unit(s, Q, K, V, Gt, O, 1536, lg2, F.lds + RING_OFF); }
        }
        SEAM(P + 2);
        if (EN(4) && IN(P + 3)) for (int rep_ = 0; rep_ < NREP(4); ++rep_) { PHASE_PTRS; diff_post(F, l, lam_init); }
        SEAM(P + 3);
        if (EN(5) && IN(P + 4)) for (int rep_ = 0; rep_ < NREP(5); ++rep_) { PHASE_PTRS;
            pg8::Gemm g{(const pg8::bf16_t*)OBR, (const pg8::bf16_t*)(ws + WS_WBR + l * SZ_WBR), NTOK, DM, 1536, 0};
            pg8::StaticOrder S; S.init(NTOK, DM, F.G, F.bx);
            pg8::EpiGate3 E{(const pg8::bf16_t*)GATES, (pg8::bf16_t*)(ws + WS_MERGED)};
            pg8::gemm_phase<pg8::EpiGate3, pg8::StaticOrder, true, true>(F.lds + RING_OFF, g, S, E);
        }
        SEAM(P + 4);
        if (EN(6) && IN(P + 5)) for (int rep_ = 0; rep_ < ((l == 0) ? NREP(6) : 1); ++rep_) { PHASE_PTRS;
            pg8::Gemm g{(const pg8::bf16_t*)(ws + WS_MERGED), (const pg8::bf16_t*)(ws + WS_WOUT + l * SZ_WOUT), NTOK, DM, DM, 0};
            pg8::StaticOrder S; S.init(NTOK, DM, F.G, F.bx);
            pg8::EpiResid E{(l == 0) ? IP(0  ) : (const float*)XR, XR, modl + 2 * 1024};
            pg8::gemm_phase<pg8::EpiResid, pg8::StaticOrder, true, true>(F.lds + RING_OFF, g, S, E);
        }
        SEAM(P + 5);
        if (EN(7) && IN(P + 6)) for (int rep_ = 0; rep_ < NREP(7); ++rep_) { PHASE_PTRS;
            LAS int* hist = (LAS int*)(F.lds + TL_HIST);
            for (int blk = F.vcu; blk < NTOK / 128; blk += F.G) {
                if (F.tid < 32) hist[F.tid] = 0;
                norm_block<false>(F, blk, XR, nullptr, nullptr, nullptr, IP(3  ) + l * DM, modl, 3, 4, H);
                __syncthreads();
                proj_block(F, blk, XR, IP(16  ) + (size_t)l * DM * NE, NE, NE, IP(3  ) + l * DM, modl, 3, 4);
                __syncthreads();
                if (F.tid < 128) { const int row = blk * 128 + F.tid;
                    float lg[32];
#pragma unroll
                    for (int e = 0; e < 32; ++e) lg[e] = proj_logit(F, F.tid, e) + IP(17  )[l * NE + e];
                    int be[4]; float bvv[4];
#pragma unroll
                    for (int k = 0; k < 4; ++k) { float best = -INFINITY; int bi = 0;
#pragma unroll
                        for (int e = 0; e < 32; ++e) { const bool take = lg[e] > best; best = take ? lg[e] : best; bi = take ? e : bi; }
                        be[k] = bi; bvv[k] = best;
#pragma unroll
                        for (int e = 0; e < 32; ++e) lg[e] = (e == bi) ? -INFINITY : lg[e]; }
                    const float e1 = __expf(bvv[1] - bvv[0]), e2 = __expf(bvv[2] - bvv[0]), e3 = __expf(bvv[3] - bvv[0]); const float inv = 1.0f / (1.0f + e1 + e2 + e3);
                    const float wk[4] = {inv, e1 * inv, e2 * inv, e3 * inv};
#pragma unroll
                    for (int k = 0; k < 4; ++k) { const int slot = row * 4 + k; const int lp = atomicAdd((int*)(hist + be[k]), 1); SLOT_E[slot] = be[k]; SLOT_LP[slot] = lp; TOPW[slot] = wk[k]; } }
                __syncthreads();
                if (F.tid < 32) LCNT[blk * 32 + F.tid] = hist[F.tid];
                __syncthreads();
            }
        }
        SEAM(P + 6);
        if (EN(8) && IN(P + 7)) for (int rep_ = 0; rep_ < NREP(8); ++rep_) { PHASE_PTRS;
            LAS int* mybase = (LAS int*)(F.lds + TL_BASE); LAS int* rowof = (LAS int*)(F.lds + TL_ROWOF);
            for (int blk = F.vcu; blk < NTOK / 128; blk += F.G) {
                if (F.tid < 64) {
                    const int e = F.lane & 31; int tot = 0, before = 0;
                    for (int j = 0; j < NTOK / 128; ++j) { const int c = LCNT[j * 32 + e]; before += (j < blk) ? c : 0; tot += c; }
                    const int pad = (tot + 255) & ~255; int inc = pad;
#pragma unroll
                    for (int o = 1; o < 32; o <<= 1) { const int nb = __shfl_up(inc, o); if ((F.lane & 31) >= o) inc += nb; }
                    const int off = inc - pad;
                    if (F.lane < 32) { mybase[e] = off + before;
                        if (blk == 0) { OFFS[e] = off; if (e == 31) OFFS[32] = off + pad;
                            for (int t = off >> 8; t < (off + pad) >> 8; ++t) TILE_E[t] = e;
                            for (int r = off + tot; r < off + pad; ++r) { SROW[r] = -1; ROWW[r] = 0.f; } } }
                }
                __syncthreads();
                { const int slot = blk * 512 + F.tid; const int e = SLOT_E[slot]; const int row = mybase[e] + SLOT_LP[slot]; SROW[row] = slot; ROWW[row] = TOPW[slot]; rowof[F.tid] = row; }
                __syncthreads();
                for (int s = F.wave * 64; s < F.wave * 64 + 64; ++s) { const int token = blk * 128 + (s >> 2); const int row = rowof[s];
                    const v4u* src = (const v4u*)(H + (size_t)token * DM); v4u* dst = (v4u*)(XG + (size_t)row * DM);
                    const v4u a = src[F.lane], bq = src[64 + F.lane]; dst[F.lane] = a; dst[64 + F.lane] = bq; }
                __syncthreads();
            }
        }
        SEAM(P + 7);
        if (EN(9) && IN(P + 8)) for (int rep_ = 0; rep_ < NREP(9); ++rep_) { PHASE_PTRS;
            const int ntiles = __builtin_amdgcn_readfirstlane(OFFS[32]) >> 8;
            pg8::Gemm g{(const pg8::bf16_t*)XG, (const pg8::bf16_t*)(ws + WS_WUP + l * SZ_WUP), MAXROWS, 2048, DM, (size_t)2048 * DM * 2};
            pg8::GroupOrder S{8, ntiles, F.G, F.bx, TILE_E};
            pg8::EpiUp E{(pg8::bf16_t*)ACT, (const float*)(ws + WS_BUP) + (size_t)l * NE * 2048};
            pg8::gemm_phase<pg8::EpiUp, pg8::GroupOrder, true, true>(F.lds + RING_OFF, g, S, E);
        }
        SEAM(P + 8);
        if (EN(10) && IN(P + 9)) for (int rep_ = 0; rep_ < NREP(10); ++rep_) { PHASE_PTRS;
            const int ntiles = __builtin_amdgcn_readfirstlane(OFFS[32]) >> 8;
            pg8::Gemm g{(const pg8::bf16_t*)ACT, (const pg8::bf16_t*)(ws + WS_WDN + l * SZ_WDN), MAXROWS, DM, DM, (size_t)DM * DM * 2};
            pg8::GroupOrder S{4, ntiles, F.G, F.bx, TILE_E};
            pg8::EpiDown E{(pg8::bf16_t*)YB, IP(21  ) + (size_t)l * NE * DM, SROW, ROWW};
            pg8::gemm_phase<pg8::EpiDown, pg8::GroupOrder, true, true>(F.lds + RING_OFF, g, S, E);
        }
        SEAM(P + 9);
    }
    if (1 < DBG_LAYERS) { constexpr int l = 1;

        const int P = 1 + l * PH_PER_LAYER;
        const float lam_init = (l == 0) ? 0.2f : 0.35550906759096926f;
        if (EN(1) && IN(P + 0)) for (int rep_ = 0; rep_ < ((l == 0) ? NREP(1) : 1); ++rep_) { PHASE_PTRS;
            for (int blk = F.vcu; blk < NTOK / 128; blk += F.G) {
                if (l == 0) norm_block<false>(F, blk, IP(0  ), nullptr, nullptr, nullptr, IP(2  ) + l * DM, modl, 0, 1, H);
                else        norm_block<true>(F, blk, XR, XR, YB, MOD + (size_t)(l - 1) * NB * 6144 + 5 * 1024, IP(2  ) + l * DM, modl, 0, 1, H);
                asm volatile("s_waitcnt vmcnt(0)" ::: "memory"); __syncthreads(); __builtin_amdgcn_fence(__ATOMIC_ACQUIRE, "agent");
                proj_block(F, blk, (l == 0) ? IP(0  ) : (const float*)XR, IP(6  ) + (size_t)l * DM * IN_COLS + 5120, IN_COLS, 8, IP(2  ) + l * DM, modl, 0, 1);
                __syncthreads();
                if (F.tid < 128) { const int row = blk * 128 + F.tid;
#pragma unroll
                    for (int e = 0; e < 8; ++e) { const float z = proj_logit(F, F.tid, e) + IP(8  )[l * 8 + e];
                        const float az = __builtin_fabsf(z); const float sp = 0.6931471805599453f * __builtin_amdgcn_logf(1.0f + __builtin_amdgcn_exp2f(-az * LOG2E));
                        LOGF[(size_t)row * 8 + e] = __builtin_fminf(z, 0.f) - sp; } }
                __syncthreads();
            }
        }
        SEAM(P + 0);
        if (EN(2) && IN(P + 1)) for (int rep_ = 0; rep_ < NREP(2); ++rep_) { PHASE_PTRS;
            LAS float* wtot = (LAS float*)(F.lds + MISC_OFF + 256);
            for (int j = F.vcu; j < NB * 8; j += F.G) {
                const int b = j >> 3, hh = j & 7; float v[4]; float run = 0.f;
#pragma unroll
                for (int q = 0; q < 4; ++q) { run += LOGF[((size_t)b * SEQ + 4 * F.tid + q) * 8 + hh]; v[q] = run; }
                float inc = run;
#pragma unroll
                for (int o = 1; o < 64; o <<= 1) { const float nb = __shfl_up(inc, o); if (F.lane >= o) inc += nb; }
                if (F.lane == 63) wtot[F.wave] = inc;
                __syncthreads();
                float base = inc - run;
                for (int w = 0; w < F.wave; ++w) base += wtot[w];
#pragma unroll
                for (int q = 0; q < 4; ++q) FBT[((size_t)b * 8 + hh) * SEQ + 4 * F.tid + q] = -LOG2E * (base + v[q]);
                __syncthreads();
            }
            pg8::Gemm g{(const pg8::bf16_t*)H, (const pg8::bf16_t*)(ws + WS_WIN + l * SZ_WIN), NTOK, 8192, DM, 0};
            pg8::StaticOrder S; S.init(NTOK, 8192, F.G, F.bx);
            pg8::EpiInProj E{(pg8::bf16_t*)PROJ, (pg8::bf16_t*)GATES, IP(7  ) + l * 3072, (const float*)(ws + WS_ROPE)};
            pg8::gemm_phase<pg8::EpiInProj, pg8::StaticOrder, true, true>(F.lds + RING_OFF, g, S, E);
        }
        SEAM(P + 1);
        if (EN(3) && IN(P + 2)) for (int rep_ = 0; rep_ < NREP(3); ++rep_) { PHASE_PTRS;
            using abf = attn_body::bf16;
            if (EN(12)) for (int rr_ = 0; rr_ < NREP(12); ++rr_) for (int j = F.vcu; j < NB * 8 * 4; j += F.G) { const int bh = j >> 2, s = j & 3, b = bh >> 3, hh = bh & 7; const size_t ro = (size_t)b * SEQ * 512 + hh * 64;
                const abf* Q = (const abf*)(PROJ + 7 * (size_t)NTOK * 512) + ro; const abf* K = (const abf*)(PROJ + 8 * (size_t)NTOK * 512) + ro; const abf* V = (const abf*)(PROJ + 9 * (size_t)NTOK * 512) + ro;
                abf* O = (abf*)OBR + (size_t)b * SEQ * 1536 + 1024 + hh * 64; const float* fb = FBT + ((size_t)b * 8 + hh) * SEQ;
                attn_body::attn_unit<8, true>(7 - s, Q, K, V, O, 1536, fb, (char*)lds + RING_OFF);
                attn_body::attn_unit<8, true>(s, Q, K, V, O, 1536, fb, (char*)lds + RING_OFF); }
            if (EN(13)) for (int rr_ = 0; rr_ < NREP(13); ++rr_) for (int j = F.vcu; j < NB * 16 * 4; j += F.G) { const int bv = j >> 2, s = j & 3, b = bv >> 4, v = bv & 15, h = v >> 2, m = (v >> 1) & 1, vh = v & 1; const size_t rb = (size_t)b * SEQ * 512;
                const abf* Q = (const abf*)(PROJ) + rb + h * 128 + m * 64; const abf* K = (const abf*)(PROJ + 1 * (size_t)NTOK * 512) + rb + h * 128 + m * 64; const abf* V = (const abf*)(PROJ + 2 * (size_t)NTOK * 512) + rb + h * 128 + vh * 64;
                abf* O = (abf*)(ws + WS_A12) + (size_t)m * NTOK * 512 + rb + h * 128 + vh * 64;
                attn_body::attn_unit<8, false>(7 - s, Q, K, V, O, 512, nullptr, (char*)lds + RING_OFF);
                attn_body::attn_unit<8, false>(s, Q, K, V, O, 512, nullptr, (char*)lds + RING_OFF); }
            if (EN(14)) for (int rr_ = 0; rr_ < NREP(14); ++rr_) for (int j = F.vcu; j < NB * 4 * 4; j += F.G) { const int bh = j >> 2, s = j & 3, b = bh >> 2, hh = bh & 3; const size_t ro = (size_t)b * SEQ * 512 + hh * 128;
                const abf* Q = (const abf*)(PROJ + 3 * (size_t)NTOK * 512) + ro; const abf* K = (const abf*)(PROJ + 4 * (size_t)NTOK * 512) + ro; const abf* V = (const abf*)(PROJ + 5 * (size_t)NTOK * 512) + ro;
                const abf* Gt = (const abf*)(PROJ + 6 * (size_t)NTOK * 512) + ro; abf* O = (abf*)OBR + (size_t)b * SEQ * 1536 + 512 + hh * 128;
                const float lg2 = log2f(1.0f - exp2f(-5.0f - (float)hh));
                ret_body::ret_unit(7 - s, Q, K, V, Gt, O, 1536, lg2, F.lds + RING_OFF);
                ret_body::ret_unit(s, Q, K, V, Gt, O, 1536, lg2, F.lds + RING_OFF); }
        }
        SEAM(P + 2);
        if (EN(4) && IN(P + 3)) for (int rep_ = 0; rep_ < NREP(4); ++rep_) { PHASE_PTRS; diff_post(F, l, lam_init); }
        SEAM(P + 3);
        if (EN(5) && IN(P + 4)) for (int rep_ = 0; rep_ < NREP(5); ++rep_) { PHASE_PTRS;
            pg8::Gemm g{(const pg8::bf16_t*)OBR, (const pg8::bf16_t*)(ws + WS_WBR + l * SZ_WBR), NTOK, DM, 1536, 0};
            pg8::StaticOrder S; S.init(NTOK, DM, F.G, F.bx);
            pg8::EpiGate3 E{(const pg8::bf16_t*)GATES, (pg8::bf16_t*)(ws + WS_MERGED)};
            pg8::gemm_phase<pg8::EpiGate3, pg8::StaticOrder, true, true>(F.lds + RING_OFF, g, S, E);
        }
        SEAM(P + 4);
        if (EN(6) && IN(P + 5)) for (int rep_ = 0; rep_ < ((l == 0) ? NREP(6) : 1); ++rep_) { PHASE_PTRS;
            pg8::Gemm g{(const pg8::bf16_t*)(ws + WS_MERGED), (const pg8::bf16_t*)(ws + WS_WOUT + l * SZ_WOUT), NTOK, DM, DM, 0};
            pg8::StaticOrder S; S.init(NTOK, DM, F.G, F.bx);
            pg8::EpiResid E{(l == 0) ? IP(0  ) : (const float*)XR, XR, modl + 2 * 1024};
            pg8::gemm_phase<pg8::EpiResid, pg8::StaticOrder, true, true>(F.lds + RING_OFF, g, S, E);
        }
        SEAM(P + 5);
        if (EN(7) && IN(P + 6)) for (int rep_ = 0; rep_ < NREP(7); ++rep_) { PHASE_PTRS;
            LAS int* hist = (LAS int*)(F.lds + TL_HIST);
            for (int blk = F.vcu; blk < NTOK / 128; blk += F.G) {
                if (F.tid < 32) hist[F.tid] = 0;
                norm_block<false>(F, blk, XR, nullptr, nullptr, nullptr, IP(3  ) + l * DM, modl, 3, 4, H);
                __syncthreads();
                proj_block(F, blk, XR, IP(16  ) + (size_t)l * DM * NE, NE, NE, IP(3  ) + l * DM, modl, 3, 4);
                __syncthreads();
                if (F.tid < 128) { const int row = blk * 128 + F.tid;
                    float lg[32];
#pragma unroll
                    for (int e = 0; e < 32; ++e) lg[e] = proj_logit(F, F.tid, e) + IP(17  )[l * NE + e];
                    int be[4]; float bvv[4];
#pragma unroll
                    for (int k = 0; k < 4; ++k) { float best = -INFINITY; int bi = 0;
#pragma unroll
                        for (int e = 0; e < 32; ++e) { const bool take = lg[e] > best; best = take ? lg[e] : best; bi = take ? e : bi; }
                        be[k] = bi; bvv[k] = best;
#pragma unroll
                        for (int e = 0; e < 32; ++e) lg[e] = (e == bi) ? -INFINITY : lg[e]; }
                    const float e1 = __expf(bvv[1] - bvv[0]), e2 = __expf(bvv[2] - bvv[0]), e3 = __expf(bvv[3] - bvv[0]); const float inv = 1.0f / (1.0f + e1 + e2 + e3);
                    const float wk[4] = {inv, e1 * inv, e2 * inv, e3 * inv};
#pragma unroll
                    for (int k = 0; k < 4; ++k) { const int slot = row * 4 + k; const int lp = atomicAdd((int*)(hist + be[k]), 1); SLOT_E[slot] = be[k]; SLOT_LP[slot] = lp; TOPW[slot] = wk[k]; } }
                __syncthreads();
                if (F.tid < 32) LCNT[blk * 32 + F.tid] = hist[F.tid];
                __syncthreads();
            }
        }
        SEAM(P + 6);
        if (EN(8) && IN(P + 7)) for (int rep_ = 0; rep_ < NREP(8); ++rep_) { PHASE_PTRS;
            LAS int* mybase = (LAS int*)(F.lds + TL_BASE); LAS int* rowof = (LAS int*)(F.lds + TL_ROWOF);
            for (int blk = F.vcu; blk < NTOK / 128; blk += F.G) {
                if (F.tid < 64) {
                    const int e = F.lane & 31; int tot = 0, before = 0;
                    for (int j = 0; j < NTOK / 128; ++j) { const int c = LCNT[j * 32 + e]; before += (j < blk) ? c : 0; tot += c; }
                    const int pad = (tot + 255) & ~255; int inc = pad;
#pragma unroll
                    for (int o = 1; o < 32; o <<= 1) { const int nb = __shfl_up(inc, o); if ((F.lane & 31) >= o) inc += nb; }
                    const int off = inc - pad;
                    if (F.lane < 32) { mybase[e] = off + before;
                        if (blk == 0) { OFFS[e] = off; if (e == 31) OFFS[32] = off + pad;
                            for (int t = off >> 8; t < (off + pad) >> 8; ++t) TILE_E[t] = e;
                            for (int r = off + tot; r < off + pad; ++r) { SROW[r] = -1; ROWW[r] = 0.f; } } }
                }
                __syncthreads();
                { const int slot = blk * 512 + F.tid; const int e = SLOT_E[slot]; const int row = mybase[e] + SLOT_LP[slot]; SROW[row] = slot; ROWW[row] = TOPW[slot]; rowof[F.tid] = row; }
                __syncthreads();
                for (int s = F.wave * 64; s < F.wave * 64 + 64; ++s) { const int token = blk * 128 + (s >> 2); const int row = rowof[s];
                    const v4u* src = (const v4u*)(H + (size_t)token * DM); v4u* dst = (v4u*)(XG + (size_t)row * DM);
                    const v4u a = src[F.lane], bq = src[64 + F.lane]; dst[F.lane] = a; dst[64 + F.lane] = bq; }
                __syncthreads();
            }
        }
        SEAM(P + 7);
        if (EN(9) && IN(P + 8)) for (int rep_ = 0; rep_ < NREP(9); ++rep_) { PHASE_PTRS;
            const int ntiles = __builtin_amdgcn_readfirstlane(OFFS[32]) >> 8;
            pg8::Gemm g{(const pg8::bf16_t*)XG, (const pg8::bf16_t*)(ws + WS_WUP + l * SZ_WUP), MAXROWS, 2048, DM, (size_t)2048 * DM * 2};
            pg8::GroupOrder S{8, ntiles, F.G, F.bx, TILE_E};
            pg8::EpiUp E{(pg8::bf16_t*)ACT, (const float*)(ws + WS_BUP) + (size_t)l * NE * 2048};
            pg8::gemm_phase<pg8::EpiUp, pg8::GroupOrder, true, true>(F.lds + RING_OFF, g, S, E);
        }
        SEAM(P + 8);
        if (EN(10) && IN(P + 9)) for (int rep_ = 0; rep_ < NREP(10); ++rep_) { PHASE_PTRS;
            const int ntiles = __builtin_amdgcn_readfirstlane(OFFS[32]) >> 8;
            pg8::Gemm g{(const pg8::bf16_t*)ACT, (const pg8::bf16_t*)(ws + WS_WDN + l * SZ_WDN), MAXROWS, DM, DM, (size_t)DM * DM * 2};
            pg8::GroupOrder S{4, ntiles, F.G, F.bx, TILE_E};
            pg8::EpiDown E{(pg8::bf16_t*)YB, IP(21  ) + (size_t)l * NE * DM, SROW, ROWW};
            pg8::gemm_phase<pg8::EpiDown, pg8::GroupOrder, true, true>(F.lds + RING_OFF, g, S, E);
        }
        SEAM(P + 9);
    }

    if (EN(11) && IN(N_PHASES - 1)) { const int l = DBG_LAYERS - 1; PHASE_PTRS; float* const outp = (float*)(GAS float*)ptr_ld(F, PT_OUT);
        const float* g2 = MOD + (size_t)(DBG_LAYERS - 1) * NB * 6144 + 5 * 1024;
        for (int row = F.vcu * NWAVES + F.wave; row < NTOK; row += F.G * NWAVES) { const int b = row >> 11;
            f32x4 v[4]; float ss = 0.f;
#pragma unroll
            for (int j = 0; j < 4; ++j) { const int c = 4 * (64 * j + F.lane); v[j] = *(const f32x4*)(XR + (size_t)row * DM + c); f32x4 a = {0.f, 0.f, 0.f, 0.f};
#pragma unroll
                for (int k = 0; k < 4; ++k) { const uint2 y = *(const uint2*)(YB + ((size_t)row * 4 + k) * DM + c); a[0] += bf_lo(y.x); a[1] += bf_hi(y.x); a[2] += bf_lo(y.y); a[3] += bf_hi(y.y); }
                if (DBG_OUT != 1) v[j] += *(const f32x4*)(g2 + (size_t)b * 6144 + c) * a; ss += (v[j][0] * v[j][0] + v[j][1] * v[j][1]) + (v[j][2] * v[j][2] + v[j][3] * v[j][3]); }
            const float rstd = 1.0f / sqrtf(wave_sum(ss) * (1.0f / DM) + NORM_EPS);
            if (DBG_OUT >= 2) {
#pragma unroll
                for (int j = 0; j < 4; ++j) { const int c = 4 * (64 * j + F.lane); f32x4 o = {0.f, 0.f, 0.f, 0.f};
                    auto addb = [&](const bf16* p) { const uint2 y = *(const uint2*)p; o[0] += bf_lo(y.x); o[1] += bf_hi(y.x); o[2] += bf_lo(y.y); o[3] += bf_hi(y.y); };
                    if (DBG_OUT == 2) { if (DBG_SEL & 1) addb(H + (size_t)row * DM + c); if (DBG_SEL & 2) for (int q = 0; q < 3; ++q) addb(GATES + (size_t)row * 3072 + q * 1024 + c); if (DBG_SEL & 4) for (int t = 0; t < 10; ++t) addb(PROJ + (size_t)t * NTOK * 512 + (size_t)row * 512 + (c & 511)); }
                    if (DBG_OUT == 3) { for (int t = 0; t < 3; ++t) addb(OBR + (size_t)row * 1536 + t * 512 + (c & 511)); for (int t = 0; t < 2; ++t) addb((const bf16*)(ws + WS_A12) + (size_t)t * NTOK * 512 + (size_t)row * 512 + (c & 511)); }
                    if (DBG_OUT == 5) { addb((const bf16*)(ws + WS_WIN) + (size_t)(row & 8191) * DM + c); }
                    if (DBG_OUT == 4) { addb((const bf16*)(ws + WS_MERGED) + (size_t)row * DM + c); }
                    *(f32x4*)(outp + (size_t)row * DM + c) = o; }
                continue; }
#pragma unroll
            for (int j = 0; j < 4; ++j) { const int c = 4 * (64 * j + F.lane); *(f32x4*)(outp + (size_t)row * DM + c) = (v[j] * rstd) * *(const f32x4*)(IP(22  ) + c); }
        }
    }
#undef IN
#undef SEAM
#undef GRID_BAR
}

extern "C" void kernel_launch(void* const* d_in, const int* in_sizes, int n_in, void* d_out, int out_size, void* d_ws, size_t ws_size, hipStream_t stream) {
    static int grid = 0;
    if (grid == 0) {
        if (n_in != 23 || in_sizes[0] != NTOK * DM || out_size != NTOK * DM || ws_size < WS_END) { fprintf(stderr, "kernel_launch: unexpected shapes (n_in %d, in0 %d, out %d, ws %zu < %zu); nothing launched\n", n_in, n_in > 0 ? in_sizes[0] : -1, out_size, ws_size, (size_t)WS_END); grid = -1; return; }
        int dev = 0, cus = 0, per_cu = 0;
        if (hipGetDevice(&dev) != hipSuccess || hipDeviceGetAttribute(&cus, hipDeviceAttributeMultiprocessorCount, dev) != hipSuccess) { grid = -1; return; }
        if (hipFuncSetAttribute((const void*)mega_fwd, hipFuncAttributeMaxDynamicSharedMemorySize, LDS_BYTES) != hipSuccess) { fprintf(stderr, "kernel_launch: hipFuncSetAttribute failed\n"); grid = -1; return; }
        if (hipOccupancyMaxActiveBlocksPerMultiprocessor(&per_cu, (const void*)mega_fwd, NWAVES * 64, LDS_BYTES) != hipSuccess || per_cu < 1) fprintf(stderr, "kernel_launch: note: occupancy query reports %d workgroups per CU\n", per_cu);
        (void)hipGetLastError();
        grid = cus;
    }
    if (grid < 0) return;
    if (hipMemsetAsync((char*)d_ws + WS_CTL, 0, CTL_ZERO_BYTES, stream) != hipSuccess) return;
    Args a{};
    const float** ip = (const float**)&a.in;
    for (int i = 0; i < 23; ++i) ip[i] = (const float*)d_in[i];
    a.out = (float*)d_out; a.ws = (unsigned char*)d_ws;
    for (int li = 0; li < N_LAUNCHES; ++li) {
        a.ph_lo = (N_LAUNCHES == 1) ? 0 : li; a.ph_hi = (N_LAUNCHES == 1) ? N_PHASES : li + 1;
        hipLaunchKernelGGL(mega_fwd, dim3(grid), dim3(NWAVES * 64), LDS_BYTES, stream, a);
        const hipError_t le = hipPeekAtLastError();
        if (le != hipSuccess) { fprintf(stderr, "kernel_launch: launch %d failed: %s\n", li, hipGetErrorName(le)); break; }
    }
}
```
